# Optimizing an MI355X kernel written in HIP

```python
import jax, jax.numpy as jnp
from jax import lax
import numpy as np

D_MODEL = 1024
BATCH = 32
SEQ = 2048
DEPTH = 2

HEAD_DIM = 64
N_ATTN_HEADS = 8
N_KV_HEADS = 2
GQA_GROUP = N_ATTN_HEADS // N_KV_HEADS
ATTN_WIDTH = N_ATTN_HEADS * HEAD_DIM
KV_WIDTH = N_KV_HEADS * HEAD_DIM
ROPE_DIM = HEAD_DIM // 4
ROPE_THETA = 500000.0
DILATED_PATTERNS = ((128, 1), (512, 4), (2048, 16))
ATTN_BLOCK = 128

SSM_HEAD_DIM = 64
SSM_HEADS = 16
SSM_INNER = SSM_HEADS * SSM_HEAD_DIM
SSM_GROUPS = 2
D_STATE = 128
CONV_WIDTH = 4
CHUNK = 128
CONV_CH = SSM_INNER + 2 * SSM_GROUPS * D_STATE

MIX_WIDTH = ATTN_WIDTH + SSM_INNER
Q_END = ATTN_WIDTH
K_END = Q_END + KV_WIDTH
V_END = K_END + KV_WIDTH
Z_END = V_END + SSM_INNER
XBC_END = Z_END + CONV_CH
IN_PROJ = XBC_END + SSM_HEADS

FFN_HIDDEN = ((8 * D_MODEL + 3 * 256 - 1) // (3 * 256)) * 256
EPS = 1e-5

kernel_name = "hybrid_dilated_attn_mamba2_block"


def rmsnorm(x, w):
    xf = x.astype(jnp.float32)
    y = xf * lax.rsqrt(jnp.mean(xf * xf, axis=-1, keepdims=True) + EPS)
    return (y * w.astype(jnp.float32)).astype(x.dtype)


def rotary_tables(positions, dtype):
    inv_freq = ROPE_THETA ** (-jnp.arange(0, ROPE_DIM, 2, dtype=jnp.float32) / ROPE_DIM)
    ang = positions.astype(jnp.float32)[..., None] * inv_freq
    return jnp.cos(ang)[:, :, None, :].astype(dtype), jnp.sin(ang)[:, :, None, :].astype(dtype)


def partial_rotary(t, cos, sin):
    half = ROPE_DIM // 2
    t1, t2, rest = t[..., :half], t[..., half:ROPE_DIM], t[..., ROPE_DIM:]
    return jnp.concatenate([t1 * cos - t2 * sin, t2 * cos + t1 * sin, rest], axis=-1)


def dilated_window_branch(q, k, v, window, dilation):
    bsz, s = q.shape[0], q.shape[1]
    length = s // dilation
    w_d = window // dilation
    nb = -(-length // ATTN_BLOCK)
    lp = nb * ATTN_BLOCK
    qd = q.reshape((bsz, length, dilation) + q.shape[2:])
    kd = k.reshape((bsz, length, dilation) + k.shape[2:])
    vd = v.reshape((bsz, length, dilation) + v.shape[2:])
    qd = jnp.pad(qd, [(0, 0), (0, lp - length)] + [(0, 0)] * (qd.ndim - 2))
    kv_pad = [(0, 0), (ATTN_BLOCK, lp - length)] + [(0, 0)] * (kd.ndim - 2)
    kd = jnp.pad(kd, kv_pad)
    vd = jnp.pad(vd, kv_pad)
    qb = qd.reshape((bsz, nb, ATTN_BLOCK) + qd.shape[2:])
    kb = kd.reshape((bsz, nb + 1, ATTN_BLOCK) + kd.shape[2:])
    vb = vd.reshape((bsz, nb + 1, ATTN_BLOCK) + vd.shape[2:])
    kb = jnp.concatenate([kb[:, :-1], kb[:, 1:]], axis=2)
    vb = jnp.concatenate([vb[:, :-1], vb[:, 1:]], axis=2)
    scores = jnp.einsum('bnqrhgc,bnkrhc->bnrhgqk', qb, kb).astype(jnp.float32)
    qi = jnp.arange(ATTN_BLOCK)[:, None]
    ki = jnp.arange(2 * ATTN_BLOCK)[None, :]
    delta = qi + ATTN_BLOCK - ki
    kpos = jnp.arange(nb)[:, None, None] * ATTN_BLOCK - ATTN_BLOCK + ki[None]
    valid = (delta >= 0)[None] & (delta <= w_d)[None] & (kpos >= 0)
    scores = jnp.where(valid[None, :, None, None, None], scores, -jnp.inf)
    m = jnp.max(scores, axis=-1, keepdims=True)
    p = jnp.exp(scores - m)
    den = jnp.sum(p, axis=-1, keepdims=True)
    o = jnp.einsum('bnrhgqk,bnkrhc->bnrhgqc', p, vb.astype(jnp.float32)) / den
    lse = (m + jnp.log(den))[..., 0]
    o = jnp.transpose(o, (0, 1, 5, 2, 3, 4, 6)).reshape((bsz, lp, dilation) + q.shape[2:])
    lse = jnp.transpose(lse, (0, 1, 5, 2, 3, 4)).reshape((bsz, lp, dilation) + q.shape[2:4])
    o = o[:, :length].reshape(q.shape)
    lse = lse[:, :length].reshape(q.shape[:4])
    return o, lse


def dilated_attention(q, k, v):
    outs, lses = [], []
    for window, dilation in DILATED_PATTERNS:
        o, l = dilated_window_branch(q, k, v, window, dilation)
        outs.append(o)
        lses.append(l)
    wts = jax.nn.softmax(jnp.stack(lses, axis=0), axis=0)
    return jnp.einsum('ibshg,ibshgc->bshgc', wts, jnp.stack(outs, axis=0))


def causal_depthwise_conv(u, w, b):
    y = lax.conv_general_dilated(u, w[:, None, :], window_strides=(1,),
                                 padding=[(CONV_WIDTH - 1, 0)],
                                 dimension_numbers=('NWC', 'WIO', 'NWC'),
                                 feature_group_count=u.shape[-1])
    return y + b


def segsum_exp(a):
    cs = jnp.cumsum(a, axis=-1)
    diff = cs[..., :, None] - cs[..., None, :]
    t = a.shape[-1]
    mask = jnp.tril(jnp.ones((t, t), dtype=bool))
    return jnp.exp(jnp.where(mask, diff, -jnp.inf))


def ssd_chunked(xs, dt, a_neg, bm, cm):
    bsz, s, nh, hp = xs.shape
    nc = s // CHUNK
    e = nh // SSM_GROUPS
    xg = (xs.astype(jnp.float32) * dt[..., None]).reshape(bsz, nc, CHUNK, SSM_GROUPS, e, hp)
    a = jnp.transpose((dt * a_neg).reshape(bsz, nc, CHUNK, SSM_GROUPS, e), (0, 1, 3, 4, 2))
    bc = bm.astype(jnp.float32).reshape(bsz, nc, CHUNK, SSM_GROUPS, D_STATE)
    cc = cm.astype(jnp.float32).reshape(bsz, nc, CHUNK, SSM_GROUPS, D_STATE)
    a_cs = jnp.cumsum(a, axis=-1)
    cb = jnp.einsum('bclgn,bcsgn->bcgls', cc, bc)
    m_mat = cb[:, :, :, None] * segsum_exp(a)
    y_diag = jnp.einsum('bcgels,bcsgep->bclgep', m_mat, xg)
    decay_states = jnp.exp(a_cs[..., -1:] - a_cs)
    states = jnp.einsum('bclgn,bcgel,bclgep->bcgepn', bc, decay_states, xg)
    chunk_decay = jnp.exp(a_cs[..., -1])

    def step(h, inp):
        dec, st = inp
        return h * dec[..., None, None] + st, h

    h0 = jnp.zeros((bsz, SSM_GROUPS, e, hp, D_STATE), jnp.float32)
    _, prev = lax.scan(step, h0, (jnp.moveaxis(chunk_decay, 1, 0), jnp.moveaxis(states, 1, 0)))
    prev_states = jnp.moveaxis(prev, 0, 1)
    y_off = jnp.einsum('bclgn,bcgepn,bcgel->bclgep', cc, prev_states, jnp.exp(a_cs))
    return (y_diag + y_off).reshape(bsz, s, nh, hp)


def hybrid_mixer(h, w_in, conv_w, conv_b, dt_bias, a_log, d_skip, ssm_norm, w_out, cos, sin):
    bsz, s, _ = h.shape
    proj = h @ w_in
    q, k, v, z, xbc, dt = jnp.split(proj, [Q_END, K_END, V_END, Z_END, XBC_END], axis=-1)
    q = partial_rotary(q.reshape(bsz, s, N_ATTN_HEADS, HEAD_DIM), cos, sin)
    k = partial_rotary(k.reshape(bsz, s, N_KV_HEADS, HEAD_DIM), cos, sin)
    v = v.reshape(bsz, s, N_KV_HEADS, HEAD_DIM)
    q = (q * (HEAD_DIM ** -0.5)).reshape(bsz, s, N_KV_HEADS, GQA_GROUP, HEAD_DIM)
    attn = dilated_attention(q, k, v).reshape(bsz, s, ATTN_WIDTH).astype(h.dtype)
    xbc = jax.nn.silu(causal_depthwise_conv(xbc, conv_w, conv_b))
    xs, bm, cm = jnp.split(xbc, [SSM_INNER, SSM_INNER + SSM_GROUPS * D_STATE], axis=-1)
    xs = xs.reshape(bsz, s, SSM_HEADS, SSM_HEAD_DIM)
    bm = bm.reshape(bsz, s, SSM_GROUPS, D_STATE)
    cm = cm.reshape(bsz, s, SSM_GROUPS, D_STATE)
    dt = jax.nn.softplus(dt.astype(jnp.float32) + dt_bias.astype(jnp.float32))
    a_neg = -jnp.exp(a_log.astype(jnp.float32))
    y = ssd_chunked(xs, dt, a_neg, bm, cm) + d_skip.astype(jnp.float32)[:, None] * xs.astype(jnp.float32)
    y = y.reshape(bsz, s, SSM_INNER).astype(h.dtype) * jax.nn.silu(z)
    gsize = SSM_INNER // SSM_GROUPS
    y = rmsnorm(y.reshape(bsz, s, SSM_GROUPS, gsize), ssm_norm.reshape(SSM_GROUPS, gsize))
    y = y.reshape(bsz, s, SSM_INNER)
    return jnp.concatenate([attn, y], axis=-1) @ w_out


def swiglu(h, w_gate, w_up, w_down):
    return (jax.nn.silu(h @ w_gate) * (h @ w_up)) @ w_down


def setup_inputs(seed: int = 0) -> dict:
    key = jax.random.key(seed)
    ks = jax.random.split(key, 16)
    f32 = jnp.float32
    x = jax.random.normal(ks[0], (BATCH, SEQ, D_MODEL), f32)
    positions = jnp.broadcast_to(jnp.arange(SEQ, dtype=jnp.int32), (BATCH, SEQ))
    norm_mix = 1.0 + 0.02 * jax.random.normal(ks[1], (DEPTH, D_MODEL), f32)
    w_in = jax.random.normal(ks[2], (DEPTH, D_MODEL, IN_PROJ), f32) * D_MODEL ** -0.5
    conv_w = jax.random.normal(ks[3], (DEPTH, CONV_WIDTH, CONV_CH), f32) * CONV_WIDTH ** -0.5
    conv_b = 0.01 * jax.random.normal(ks[4], (DEPTH, CONV_CH), f32)
    dt0 = jnp.exp(jax.random.uniform(ks[5], (DEPTH, SSM_HEADS), f32, np.log(1e-3), np.log(1e-1)))
    dt_bias = dt0 + jnp.log(-jnp.expm1(-dt0))
    a_log = jnp.log(jax.random.uniform(ks[6], (DEPTH, SSM_HEADS), f32, 1.0, 16.0))
    d_skip = 1.0 + 0.1 * jax.random.normal(ks[7], (DEPTH, SSM_HEADS), f32)
    ssm_norm = 1.0 + 0.02 * jax.random.normal(ks[8], (DEPTH, SSM_INNER), f32)
    w_out = jax.random.normal(ks[9], (DEPTH, MIX_WIDTH, D_MODEL), f32) * MIX_WIDTH ** -0.5
    norm_ffn = 1.0 + 0.02 * jax.random.normal(ks[10], (DEPTH, D_MODEL), f32)
    w_gate = jax.random.normal(ks[11], (DEPTH, D_MODEL, FFN_HIDDEN), f32) * D_MODEL ** -0.5
    w_up = jax.random.normal(ks[12], (DEPTH, D_MODEL, FFN_HIDDEN), f32) * D_MODEL ** -0.5
    w_down = jax.random.normal(ks[13], (DEPTH, FFN_HIDDEN, D_MODEL), f32) * FFN_HIDDEN ** -0.5
    final_norm = 1.0 + 0.02 * jax.random.normal(ks[14], (D_MODEL,), f32)
    return {"x": x, "positions": positions, "norm_mix": norm_mix, "w_in": w_in,
            "conv_w": conv_w, "conv_b": conv_b, "dt_bias": dt_bias, "a_log": a_log,
            "d_skip": d_skip, "ssm_norm": ssm_norm, "w_out": w_out, "norm_ffn": norm_ffn,
            "w_gate": w_gate, "w_up": w_up, "w_down": w_down, "final_norm": final_norm}


def reference(x, positions, norm_mix, w_in, conv_w, conv_b, dt_bias, a_log, d_skip, ssm_norm,
              w_out, norm_ffn, w_gate, w_up, w_down, final_norm):
    cos, sin = rotary_tables(positions, x.dtype)
    h = x
    for layer in range(DEPTH):
        h = h + hybrid_mixer(rmsnorm(h, norm_mix[layer]), w_in[layer], conv_w[layer],
                             conv_b[layer], dt_bias[layer], a_log[layer], d_skip[layer],
                             ssm_norm[layer], w_out[layer], cos, sin)
        h = h + swiglu(rmsnorm(h, norm_ffn[layer]), w_gate[layer], w_up[layer], w_down[layer])
    return rmsnorm(h, final_norm)
```

```cpp
#include <hip/hip_runtime.h>
#include <hip/hip_cooperative_groups.h>
#include <cstdio>
#include <cmath>
namespace cg = cooperative_groups;
#ifndef PHM
#define PHM 511
#endif
#ifndef ONE_LAUNCH
#define ONE_LAUNCH 1
#endif
namespace pg8 {
#define PG8_LAS __attribute__((address_space(3)))
typedef unsigned short bf16_t;
typedef short bf16x8 __attribute__((ext_vector_type(8)));
typedef float f32x4 __attribute__((ext_vector_type(4)));
typedef unsigned u32x4 __attribute__((ext_vector_type(4)));
constexpr int BM = 256, BK = 64, HALF = 128, HTB = HALF * BK * 2  , STAGE_BYTES = 8 * HTB, NXCD = 8, WGM = 8;

__host__ __device__ __forceinline__ int lds_byte(int r, int c) { const int st = (r >> 4) * 2 + (c >> 5), rr = r & 15, cc = c & 31, ob = rr * 64 + cc * 2; return st * 1024 + (ob ^ (((ob >> 9) & 1) << 5)); }
__host__ __device__ __forceinline__ void stage_rc(int b, int& R, int& C) { const int st = b / 1024, sb = b % 1024, swz = sb ^ (((sb >> 9) & 1) << 5); R = (st >> 1) * 16 + swz / 64; C = (st & 1) * 32 + (swz % 64) / 2; }
__host__ __device__ __forceinline__ int perm32(int rho) { const int n = rho >> 4, i = rho & 15; return 8 * (i >> 2) + 4 * n + (i & 3); }

struct Unit { int pm, pn; };
struct Gemm { const bf16_t* A; const bf16_t* Bt; int M, N, K; };

struct StaticOrder {
    int nM, nN, nwg, G, c;
    __host__ __device__ void init(int M, int N, int G_, int c_) { nM = M / BM; nN = N / BM; nwg = nM * nN; G = G_; c = c_; }
    __host__ __device__ bool next(int i, Unit& u) const {
        const long L = (long)i * G + c; if (L >= nwg) return false;
        int wgid = (int)L; { const int q = nwg / NXCD, r = nwg % NXCD, xcd = wgid % NXCD, off = wgid / NXCD; wgid = (xcd < r ? xcd * (q + 1) : r * (q + 1) + (xcd - r) * q) + off; }
        const int nig = WGM * nN, gid = wgid / nig, fm = gid * WGM, gsz = (nM - fm) < WGM ? (nM - fm) : WGM;
        u.pm = fm + ((wgid % nig) % gsz); u.pn = (wgid % nig) / gsz; return true;
    }
    __device__ __forceinline__ void a_ready(const Unit&) const {}
    __device__ __forceinline__ void done(const Unit&) const {}
};
__device__ __forceinline__ unsigned cvt_pk_bf16(float lo, float hi) { unsigned r; asm volatile("v_cvt_pk_bf16_f32 %0, %1, %2" : "=v"(r) : "v"(lo), "v"(hi)); return r; }
typedef float f32x2 __attribute__((ext_vector_type(2)));
template <class Epi, class Sched, bool STAMP = false>
__device__ __forceinline__ void gemm_phase(PG8_LAS unsigned char* lds, const Gemm g, const Sched& S, const Epi& E, unsigned long long* stamps) {
    int tid_ = threadIdx.x; asm volatile("" : "+v"(tid_));
    const int tid = tid_, wid = __builtin_amdgcn_readfirstlane(tid >> 6), lane = tid & 63, wr = wid >> 2, wc = wid & 3, fr = lane & 15, fq = lane >> 4;
    const int K = g.K, nt = K / BK;
    int ts_lo = 0, ts_hi = 0, nts = 0; const unsigned long long rt_entry = STAMP ? (unsigned long long)wall_clock64() : 0ull;
#define PG8_STAMP() do { if (STAMP && wid == 0 && nts < 64) { const unsigned long long _c = (unsigned long long)clock64(); \
        ts_lo = (lane == nts) ? (int)(unsigned)_c : ts_lo; ts_hi = (lane == nts) ? (int)(unsigned)(_c >> 32) : ts_hi; ++nts; } } while (0)
    PG8_STAMP();
    unsigned voffA[2], voffB[2];
#pragma unroll
    for (int i = 0; i < 2; ++i) { int R, C; stage_rc(tid * 16 + i * 8192, R, C); const int Rb = Epi::PERM ? ((R & ~31) + perm32(R & 31)) : R;
        voffA[i] = (unsigned)(R * K + C) * 2u; voffB[i] = (unsigned)(Rb * K + C) * 2u; }
    const size_t kstep = (size_t)(BK * 2);
    const size_t hstep = (size_t)HALF * K * 2;
    const size_t tstep = 2 * hstep;
    const unsigned ldsw = (unsigned)wid * 1024u;
    const int aoff = lds_byte(wr * 64 + fr, fq * 8), boff = lds_byte(wc * 32 + fr, fq * 8);
#define PG8_SA(b, h) (((b) * 2 + (h)) * HTB)
#define PG8_SB(b, h) ((4 + (b) * 2 + (h)) * HTB)
#define PG8_STAGE(bufoff, gbase, voff) do { _Pragma("unroll") for (int _i = 0; _i < 2; ++_i) \
        __builtin_amdgcn_global_load_lds((const unsigned*)((const char*)(gbase) + (voff)[_i]), (PG8_LAS unsigned*)(lds + (bufoff) + ldsw + _i * 8192), 16, 0, 0); } while (0)
#define PG8_LDA(dst, b, h) do { _Pragma("unroll") for (int m = 0; m < 4; ++m) _Pragma("unroll") for (int k = 0; k < 2; ++k) dst[m][k] = *(const PG8_LAS bf16x8*)(lds + PG8_SA(b, h) + aoff + m * 2048 + k * 1024); } while (0)
#define PG8_LDB(dst, b, h) do { _Pragma("unroll") for (int n = 0; n < 2; ++n) _Pragma("unroll") for (int k = 0; k < 2; ++k) dst[n][k] = *(const PG8_LAS bf16x8*)(lds + PG8_SB(b, h) + boff + n * 2048 + k * 1024); } while (0)
#define PG8_MMA(ai, bj, At, Bt) do { __builtin_amdgcn_s_setprio(1); _Pragma("unroll") for (int m = 0; m < 4; ++m) _Pragma("unroll") for (int n = 0; n < 2; ++n) _Pragma("unroll") for (int k = 0; k < 2; ++k) \
        acc[ai][bj][m][n] = __builtin_amdgcn_mfma_f32_16x16x32_bf16(Bt[n][k], At[m][k], acc[ai][bj][m][n], 0, 0, 0); __builtin_amdgcn_s_setprio(0); } while (0)
#define PG8_WAIT_V(n) asm volatile("s_waitcnt vmcnt(" #n ")" ::: "memory")
#define PG8_WAIT_L(n) asm volatile("s_waitcnt lgkmcnt(" #n ")" ::: "memory")
#define PG8_BAR __builtin_amdgcn_s_barrier()
#define PG8_SCHED __builtin_amdgcn_sched_barrier(0)
    Unit cur, nxt; int ui = 0;
    if (!S.next(0, cur)) return;
    f32x4 acc[2][2][4][2];
#pragma unroll
    for (int a = 0; a < 2; ++a)
#pragma unroll
        for (int b = 0; b < 2; ++b)
#pragma unroll
            for (int m = 0; m < 4; ++m)
#pragma unroll
                for (int n = 0; n < 2; ++n) acc[a][b][m][n] = (f32x4){0.f, 0.f, 0.f, 0.f};
    bf16x8 At[4][2], B0[2][2], B1[2][2];
    const char* cA = (const char*)g.A + (size_t)cur.pm * tstep; const char* cB = (const char*)g.Bt + (size_t)cur.pn * tstep;
    S.a_ready(cur);
    PG8_STAGE(PG8_SB(0, 0), cB, voffB); PG8_STAGE(PG8_SA(0, 0), cA, voffA); PG8_STAGE(PG8_SB(0, 1), cB + hstep, voffB); PG8_STAGE(PG8_SA(0, 1), cA + hstep, voffA);
    if (wr == 1) PG8_BAR;
    PG8_WAIT_V(4); PG8_BAR;
    PG8_STAGE(PG8_SB(1, 0), cB + kstep, voffB); PG8_STAGE(PG8_SA(1, 0), cA + kstep, voffA); PG8_STAGE(PG8_SB(1, 1), cB + hstep + kstep, voffB);
    PG8_WAIT_V(6); PG8_BAR;
    PG8_STAMP();
    for (;;) {
        const bool has_next = S.next(ui + 1, nxt);
        const char* nA = has_next ? (const char*)g.A + (size_t)nxt.pm * tstep : cA; const char* nB = has_next ? (const char*)g.Bt + (size_t)nxt.pn * tstep : cB;
        for (int t = 0; t < nt; t += 2) {
            const bool last = (t == nt - 2);
            const char* a1 = cA + (size_t)(t + 1) * kstep;
            const char* a2 = last ? nA : cA + (size_t)(t + 2) * kstep; const char* b2 = last ? nB : cB + (size_t)(t + 2) * kstep;
            const char* a3 = a2 + kstep; const char* b3 = b2 + kstep;
            if (last && has_next) S.a_ready(nxt);
            PG8_LDB(B0, 0, 0); PG8_SCHED; PG8_LDA(At, 0, 0); PG8_STAGE(PG8_SA(1, 1), a1 + hstep, voffA);
            PG8_WAIT_L(8); PG8_BAR; PG8_WAIT_L(0); PG8_MMA(0, 0, At, B0); PG8_BAR; PG8_SCHED;
            PG8_LDB(B1, 0, 1); PG8_STAGE(PG8_SB(0, 0), b2, voffB);
            PG8_BAR; PG8_WAIT_L(0); PG8_MMA(0, 1, At, B1); PG8_BAR;
            PG8_LDA(At, 0, 1); PG8_STAGE(PG8_SA(0, 0), a2, voffA);
            PG8_BAR; PG8_WAIT_L(0); PG8_MMA(1, 0, At, B0); PG8_BAR; PG8_SCHED;
            PG8_STAGE(PG8_SB(0, 1), b2 + hstep, voffB);
            PG8_WAIT_V(6); PG8_BAR; PG8_MMA(1, 1, At, B1); PG8_BAR;
            PG8_LDB(B0, 1, 0); PG8_SCHED; PG8_LDA(At, 1, 0); PG8_STAGE(PG8_SA(0, 1), a2 + hstep, voffA);
            PG8_WAIT_L(8); PG8_BAR; PG8_WAIT_L(0); PG8_MMA(0, 0, At, B0); PG8_BAR; PG8_SCHED;
            PG8_LDB(B1, 1, 1); PG8_STAGE(PG8_SB(1, 0), b3, voffB);
            PG8_BAR; PG8_WAIT_L(0); PG8_MMA(0, 1, At, B1); PG8_BAR;
            PG8_LDA(At, 1, 1); PG8_STAGE(PG8_SA(1, 0), a3, voffA);
            PG8_BAR; PG8_WAIT_L(0); PG8_MMA(1, 0, At, B0); PG8_BAR; PG8_SCHED;
            PG8_STAGE(PG8_SB(1, 1), b3 + hstep, voffB);
            PG8_WAIT_V(6); PG8_BAR; PG8_MMA(1, 1, At, B1); PG8_BAR;
        }
        PG8_STAMP();
        if constexpr (!Epi::AFTER_DRAIN) { E(acc, cur, wr, wc, fr, fq); S.done(cur); }
        PG8_STAMP();
        if (!has_next) break;
#pragma unroll
        for (int a = 0; a < 2; ++a)
#pragma unroll
            for (int b = 0; b < 2; ++b)
#pragma unroll
                for (int m = 0; m < 4; ++m)
#pragma unroll
                    for (int n = 0; n < 2; ++n) acc[a][b][m][n] = (f32x4){0.f, 0.f, 0.f, 0.f};
        cur = nxt; cA = nA; cB = nB; ++ui;
    }
    PG8_WAIT_V(0);
    if (wr == 0) PG8_BAR;
    PG8_BAR;
    if constexpr (Epi::AFTER_DRAIN) { E.fused(acc, cur, wr, wc, fr, fq, lds, wid, lane); S.done(cur); }
    PG8_STAMP();
    if (STAMP && wid == 0) { stamps[lane] = lane < nts ? (((unsigned long long)(unsigned)ts_hi << 32) | (unsigned)ts_lo) : 0ull;
        if (lane == 62) stamps[62] = rt_entry; if (lane == 63) stamps[63] = (unsigned long long)wall_clock64(); }
#undef PG8_STAMP
#undef PG8_SA
#undef PG8_SB
#undef PG8_STAGE
#undef PG8_LDA
#undef PG8_LDB
#undef PG8_MMA
#undef PG8_WAIT_V
#undef PG8_WAIT_L
#undef PG8_BAR
#undef PG8_SCHED
}
}

namespace pg8 {
__device__ __forceinline__ float silu_f(float x) { return x * __builtin_amdgcn_rcpf(1.0f + __expf(-x)); }

struct EpiInProj {
    static constexpr bool PERM = true, AFTER_DRAIN = false;
    bf16_t* P; float* DT; const float* CS; const float* dt_bias;
    __device__ __forceinline__ void operator()(const f32x4 (&acc)[2][2][4][2], const Unit& u, int wr, int wc, int fr, int fq) const {
        const int row0 = u.pm * BM + wr * 64 + fr; const int pn = u.pn;
        if (pn == 13) {
            if (wc == 0 && fq < 2) {
                const f32x4 b0 = *(const f32x4*)(dt_bias + 8 * fq), b1 = *(const f32x4*)(dt_bias + 8 * fq + 4);
#pragma unroll
                for (int ai = 0; ai < 2; ++ai)
#pragma unroll
                    for (int m = 0; m < 4; ++m) { const int row = row0 + ai * HALF + m * 16;
                        f32x4 v0 = acc[ai][0][m][0] + b0, v1 = acc[ai][0][m][1] + b1;
#pragma unroll
                        for (int e = 0; e < 4; ++e) { v0[e] = v0[e] > 20.f ? v0[e] : log1pf(__expf(v0[e])); v1[e] = v1[e] > 20.f ? v1[e] : log1pf(__expf(v1[e])); }
                        *(f32x4*)(DT + (size_t)row * 16 + 8 * fq) = v0; *(f32x4*)(DT + (size_t)row * 16 + 8 * fq + 4) = v1; }
            }
            return;
        }
        const bool rot_wave = (pn < 3) && ((wc & 1) == 0);
#pragma unroll
        for (int ai = 0; ai < 2; ++ai)
#pragma unroll
            for (int m = 0; m < 4; ++m) { const int row = row0 + ai * HALF + m * 16;
                f32x4 c0 = {1.f, 1.f, 1.f, 1.f}, c1 = c0, s0 = {0.f, 0.f, 0.f, 0.f}, s1 = s0;
                if (rot_wave) { const float* cs = CS + (size_t)row * 16; c0 = *(const f32x4*)(cs); c1 = *(const f32x4*)(cs + 4); s0 = *(const f32x4*)(cs + 8); s1 = *(const f32x4*)(cs + 12); }
                bf16_t* rowp = P + (size_t)row * 3328 + pn * 256 + wc * 32 + 8 * fq;
#pragma unroll
                for (int bj = 0; bj < 2; ++bj) { f32x4 v0 = acc[ai][bj][m][0], v1 = acc[ai][bj][m][1];
                    const bool rope = rot_wave && (pn < 2 || bj == 0);
                    if (rope) { f32x4 p0, p1;
#pragma unroll
                        for (int e = 0; e < 4; ++e) { p0[e] = __shfl_xor(v0[e], 16); p1[e] = __shfl_xor(v1[e], 16); }
                        if (fq < 2) { const float sg = fq == 0 ? -1.f : 1.f; v0 = v0 * c0 + sg * (p0 * s0); v1 = v1 * c1 + sg * (p1 * s1); } }
                    if (pn < 2) { v0 = v0 * 0.125f; v1 = v1 * 0.125f; }
                    u32x4 w; w.x = cvt_pk_bf16(v0[0], v0[1]); w.y = cvt_pk_bf16(v0[2], v0[3]); w.z = cvt_pk_bf16(v1[0], v1[1]); w.w = cvt_pk_bf16(v1[2], v1[3]);
                    *(u32x4*)(rowp + bj * HALF) = w; } }
    }
};
struct EpiRes {
    static constexpr bool PERM = false, AFTER_DRAIN = false;
    const float* base; float* out; int ldc;
    __device__ __forceinline__ void operator()(const f32x4 (&acc)[2][2][4][2], const Unit& u, int wr, int wc, int fr, int fq) const {
        const int row0 = u.pm * BM + wr * 64 + fr, col0 = u.pn * BM + wc * 32 + 4 * fq;
#pragma unroll
        for (int ai = 0; ai < 2; ++ai)
#pragma unroll
            for (int m = 0; m < 4; ++m) { const size_t off = (size_t)(row0 + ai * HALF + m * 16) * ldc + col0;
#pragma unroll
                for (int bj = 0; bj < 2; ++bj)
#pragma unroll
                    for (int n = 0; n < 2; ++n) { const f32x4 b = *(const f32x4*)(base + off + bj * HALF + n * 16); *(f32x4*)(out + off + bj * HALF + n * 16) = b + acc[ai][bj][m][n]; } }
    }
};
struct EpiGateUp {
    static constexpr bool PERM = true, AFTER_DRAIN = false;
    bf16_t* H;
    __device__ __forceinline__ void operator()(const f32x4 (&acc)[2][2][4][2], const Unit& u, int wr, int wc, int fr, int fq) const {
        const int row0 = u.pm * BM + wr * 64 + fr, col0 = u.pn * HALF + wc * 32 + 8 * fq;
#pragma unroll
        for (int ai = 0; ai < 2; ++ai)
#pragma unroll
            for (int m = 0; m < 4; ++m) { const f32x4 g0 = acc[ai][0][m][0], g1 = acc[ai][0][m][1], u0 = acc[ai][1][m][0], u1 = acc[ai][1][m][1]; f32x4 h0, h1;
#pragma unroll
                for (int e = 0; e < 4; ++e) { h0[e] = silu_f(g0[e]) * u0[e]; h1[e] = silu_f(g1[e]) * u1[e]; }
                u32x4 w; w.x = cvt_pk_bf16(h0[0], h0[1]); w.y = cvt_pk_bf16(h0[2], h0[3]); w.z = cvt_pk_bf16(h1[0], h1[1]); w.w = cvt_pk_bf16(h1[2], h1[3]);
                *(u32x4*)(H + (size_t)(row0 + ai * HALF + m * 16) * 2816 + col0) = w; }
    }
};
}

#define LAS __attribute__((address_space(3)))
typedef unsigned short bf16;
typedef float f32x4 __attribute__((ext_vector_type(4)));
typedef unsigned u32x4 __attribute__((ext_vector_type(4)));
typedef unsigned u32x2 __attribute__((ext_vector_type(2)));

constexpr int NTOK = 65536, DM = 1024, SEQ = 2048;
constexpr int NPROJ = 3328, NPROJ_PAD = 3584, NPROJ_SRC = 3344, MIXW = 1536, FFN = 2816, CONVCH = 1536;
constexpr size_t MiB = 1u << 20;
constexpr size_t WS_WIN = 1 * MiB, WS_WOUT = 15 * MiB, WS_WGU = 21 * MiB, WS_WDN = 43 * MiB, WS_CS = 54 * MiB, WS_DT = 58 * MiB, WS_SSQ = 62 * MiB,
                 WS_XN = 66 * MiB, WS_PROJ = 194 * MiB, WS_MIX = 610 * MiB, WS_END = 802 * MiB;
constexpr int LDS_BYTES = 147456;
constexpr int NPHASE = 17;

__device__ __forceinline__ float bf2f(unsigned short b) { return __uint_as_float(((unsigned)b) << 16); }
__device__ __forceinline__ unsigned f2bf(float f) { unsigned u = __float_as_uint(f); return (u + 0x7fffu + ((u >> 16) & 1u)) >> 16; }
__device__ __forceinline__ unsigned pk2(float lo, float hi) { return f2bf(lo) | (f2bf(hi) << 16); }
__device__ __forceinline__ float silu(float x) { return x * __builtin_amdgcn_rcpf(1.0f + __expf(-x)); }
__device__ __forceinline__ float wave_sum(float v) {
#pragma unroll
    for (int o = 1; o < 64; o <<= 1) v += __shfl_xor(v, o);
    return v;
}
__device__ __forceinline__ float wave_max(float v) {
#pragma unroll
    for (int o = 1; o < 64; o <<= 1) v = fmaxf(v, __shfl_xor(v, o));
    return v;
}
#define LDS_WAIT() asm volatile("s_waitcnt lgkmcnt(0)" ::: "memory")

struct Args { const float* in[16]; float* out; unsigned char* ws; float inv_freq[8]; int ph_lo, ph_hi; };
typedef const __attribute__((address_space(4))) Args* ArgsP;

__device__ __forceinline__ void transpose_item(const float* W, int Nsrc, int K, bf16* WT, int k0, int n0, int drow0, LAS float* scr, int lane) {
#pragma unroll 8
    for (int i = 0; i < 32; ++i) { const int kk = 2 * i + (lane >> 5), n = n0 + (lane & 31); scr[kk * 33 + (lane & 31)] = n < Nsrc ? W[(size_t)(k0 + kk) * Nsrc + n] : 0.f; }
    LDS_WAIT();
    const int c = lane & 7;
#pragma unroll
    for (int j = 0; j < 4; ++j) { const int nn = (lane >> 3) + 8 * j; const LAS float* s = scr + (8 * c) * 33 + nn;
        u32x4 o; o.x = pk2(s[0 * 33], s[1 * 33]); o.y = pk2(s[2 * 33], s[3 * 33]); o.z = pk2(s[4 * 33], s[5 * 33]); o.w = pk2(s[6 * 33], s[7 * 33]);
        *(u32x4*)(WT + (size_t)(drow0 + nn) * K + k0 + 8 * c) = o; }
    LDS_WAIT();
}

template <bool TOF32>
__device__ __forceinline__ void rms_row(const float* xrow, const float* w, void* orow, int lane) {
    const f32x4* xr = (const f32x4*)xrow + lane; const f32x4* wr = (const f32x4*)w + lane;
    f32x4 v[4]; float s = 0.f;
#pragma unroll
    for (int j = 0; j < 4; ++j) { v[j] = xr[64 * j]; s += (v[j].x * v[j].x + v[j].y * v[j].y) + (v[j].z * v[j].z + v[j].w * v[j].w); }
    const float rstd = 1.0f / sqrtf(wave_sum(s) * (1.f / 1024.f) + 1e-5f);
#pragma unroll
    for (int j = 0; j < 4; ++j) { const f32x4 ww = wr[64 * j]; const f32x4 o = v[j] * rstd * ww;
        if (TOF32) ((f32x4*)orow)[lane + 64 * j] = o;
        else { u32x2 pk; pk.x = pk2(o.x, o.y); pk.y = pk2(o.z, o.w); ((u32x2*)orow)[lane + 64 * j] = pk; } }
}

__device__ __forceinline__ void phase_prologue(ArgsP a, LAS unsigned char* lds, int wave, int lane) {
    unsigned char* ws = a->ws;
    LAS float* scr = (LAS float*)(lds + wave * 16384);
    const int gw = blockIdx.x * 8 + wave, NGW = gridDim.x * 8;
    constexpr int I_IN = 16 * 112, I_OUT = 24 * 32, I_G = 16 * 88, I_D = 44 * 32, I_LAYER = I_IN + I_OUT + 2 * I_G + I_D;
    for (int it = gw; it < 2 * I_LAYER; it += NGW) {
        const int l = it / I_LAYER; int r = it - l * I_LAYER;
        if (r < I_IN) { const int kb = r / 112, nb = r % 112; transpose_item(a->in[3] + (size_t)l * DM * NPROJ_SRC, NPROJ_SRC, DM, (bf16*)(ws + WS_WIN) + (size_t)l * NPROJ_PAD * DM, kb * 64, nb * 32, nb * 32, scr, lane); continue; } r -= I_IN;
        if (r < I_OUT) { const int kb = r / 32, nb = r % 32; transpose_item(a->in[10] + (size_t)l * MIXW * DM, DM, MIXW, (bf16*)(ws + WS_WOUT) + (size_t)l * DM * MIXW, kb * 64, nb * 32, nb * 32, scr, lane); continue; } r -= I_OUT;
        if (r < 2 * I_G) { const int s = r / I_G; r -= s * I_G; const int kb = r / 88, nb = r % 88, n0 = nb * 32;
            transpose_item((s ? a->in[13] : a->in[12]) + (size_t)l * DM * FFN, FFN, DM, (bf16*)(ws + WS_WGU) + (size_t)l * 2 * FFN * DM, kb * 64, n0, 256 * (n0 >> 7) + 128 * s + (n0 & 127), scr, lane); continue; } r -= 2 * I_G;
        { const int kb = r / 32, nb = r % 32; transpose_item(a->in[14] + (size_t)l * FFN * DM, DM, FFN, (bf16*)(ws + WS_WDN) + (size_t)l * DM * FFN, kb * 64, nb * 32, nb * 32, scr, lane); }
    }
    const int* pos = (const int*)a->in[1]; float* CS = (float*)(ws + WS_CS);
    for (int idx = gw * 64 + lane; idx < NTOK * 8; idx += NGW * 64) { const int row = idx >> 3, i = idx & 7;
        const float fr_ = i == 0 ? a->inv_freq[0] : i == 1 ? a->inv_freq[1] : i == 2 ? a->inv_freq[2] : i == 3 ? a->inv_freq[3] : i == 4 ? a->inv_freq[4] : i == 5 ? a->inv_freq[5] : i == 6 ? a->inv_freq[6] : a->inv_freq[7];
        const float ang = (float)pos[row] * fr_; const double ad = (double)ang; const double k = rint(ad * 0.15915494309189535); const float r = (float)(ad - k * 6.283185307179586);
        CS[(size_t)row * 16 + i] = __cosf(r); CS[(size_t)row * 16 + 8 + i] = __sinf(r); }
    for (int m = gw; m < NTOK; m += NGW) rms_row<false>(a->in[0] + (size_t)m * DM, a->in[2], (bf16*)(ws + WS_XN) + (size_t)m * DM, lane);
}

__device__ __forceinline__ void ssd_valu(ArgsP a, int layer, LAS unsigned char* lds, int tid, int lane) {
    unsigned char* ws = a->ws;
    const bf16* PROJ = (const bf16*)(ws + WS_PROJ); bf16* MIX = (bf16*)(ws + WS_MIX); const float* DT = (const float*)(ws + WS_DT); float* SSQ = (float*)(ws + WS_SSQ);
    const float* conv_w = a->in[4] + (size_t)layer * 4 * CONVCH; const float* conv_b = a->in[5] + (size_t)layer * CONVCH;
    LAS float* XS = (LAS float*)lds; LAS float* BS = XS + 4096; LAS float* CSm = BS + 8192; LAS float* YS = CSm + 8192; LAS float* DTS = YS + 4096; LAS float* DAS = DTS + 64;
    const int p = tid >> 3, ns = tid & 7;
    for (int item = blockIdx.x; item < 512; item += gridDim.x) {
        const int b = item >> 4, hh = item & 15, g = hh >> 3;
        const float A = -__expf(a->in[7][layer * 16 + hh]), Dk = a->in[8][layer * 16 + hh];
        float h[16];
#pragma unroll
        for (int j = 0; j < 16; ++j) h[j] = 0.f;
        for (int t0 = 0; t0 < SEQ; t0 += 64) {
            for (int idx = tid; idx < 64 * 320; idx += 512) { const int tl = idx / 320, ch = idx - tl * 320;
                const int xch = ch < 64 ? hh * 64 + ch : (ch < 192 ? 1024 + g * 128 + (ch - 64) : 1280 + g * 128 + (ch - 192));
                const int t = t0 + tl; float acc = conv_b[xch];
#pragma unroll
                for (int k = 0; k < 4; ++k) { const int tt = t - 3 + k; if (tt >= 0) acc += conv_w[k * CONVCH + xch] * bf2f(PROJ[(size_t)(b * SEQ + tt) * NPROJ + 1792 + xch]); }
                const float v = silu(acc);
                if (ch < 64) XS[tl * 64 + ch] = v; else if (ch < 192) BS[tl * 128 + ch - 64] = v; else CSm[tl * 128 + ch - 192] = v; }
            if (tid < 64) { const float dt = DT[(size_t)(b * SEQ + t0 + tid) * 16 + hh]; DTS[tid] = dt; DAS[tid] = __expf(dt * A); }
            __syncthreads();
#pragma unroll 2
            for (int tl = 0; tl < 64; ++tl) { const float dt = DTS[tl], dA = DAS[tl], xv = XS[tl * 64 + p], dtx = dt * xv; float yp = 0.f;
#pragma unroll
                for (int q = 0; q < 4; ++q) { const f32x4 b4 = *(const LAS f32x4*)(BS + tl * 128 + ns * 16 + q * 4), c4 = *(const LAS f32x4*)(CSm + tl * 128 + ns * 16 + q * 4);
#pragma unroll
                    for (int e = 0; e < 4; ++e) { h[4 * q + e] = h[4 * q + e] * dA + dtx * b4[e]; yp += h[4 * q + e] * c4[e]; } }
                yp += __shfl_xor(yp, 1); yp += __shfl_xor(yp, 2); yp += __shfl_xor(yp, 4);
                if (ns == 0) YS[tl * 64 + p] = yp + Dk * xv; }
            __syncthreads();
            for (int idx = tid; idx < 4096; idx += 512) { const int tl = idx >> 6, pp = idx & 63; const size_t row = (size_t)(b * SEQ + t0 + tl);
                const float y = YS[idx], z = bf2f(PROJ[row * NPROJ + 768 + hh * 64 + pp]), yg = y * silu(z);
                MIX[row * MIXW + 512 + hh * 64 + pp] = (bf16)f2bf(yg);
                const float ss = wave_sum(yg * yg); if (lane == 0) SSQ[row * 16 + hh] = ss; }
        }
        __syncthreads();
    }
}

__device__ __forceinline__ void attn_valu(ArgsP a, LAS unsigned char* lds, int wave, int lane) {
    unsigned char* ws = a->ws;
    const bf16* PROJ = (const bf16*)(ws + WS_PROJ); bf16* MIX = (bf16*)(ws + WS_MIX);
    LAS float* QS = (LAS float*)lds + wave * 2048; LAS float* PS = QS + 256;
    const int per = NTOK / gridDim.x;
    for (int it = wave; it < per * 2; it += 8) {
        const int tok = blockIdx.x * per + (it >> 1), kvh = it & 1, t = tok & (SEQ - 1); const size_t seq0 = (size_t)(tok - t);
#pragma unroll
        for (int g = 0; g < 4; ++g) QS[g * 64 + lane] = bf2f(PROJ[(size_t)tok * NPROJ + (kvh * 4 + g) * 64 + lane]);
        LDS_WAIT();
        float m0 = -1e30f, m1 = -1e30f, m2 = -1e30f, m3 = -1e30f;
#pragma unroll 1
        for (int ps = 0; ps < 7; ++ps) { const int j = ps * 64 + lane, br = j < 129 ? 0 : (j < 258 ? 1 : 2), jj = j - 129 * br, kpos = t - (jj << (2 * br)); const bool valid = (j < 387) && (kpos >= 0);
            const bf16* kptr = PROJ + (seq0 + (size_t)(valid ? kpos : t)) * NPROJ + 512 + kvh * 64;
            float s0 = 0.f, s1 = 0.f, s2 = 0.f, s3 = 0.f;
#pragma unroll 2
            for (int d8 = 0; d8 < 8; ++d8) { const u32x4 kv = *(const u32x4*)(kptr + d8 * 8); float kf[8];
                kf[0] = __uint_as_float(kv.x << 16); kf[1] = __uint_as_float(kv.x & 0xffff0000u); kf[2] = __uint_as_float(kv.y << 16); kf[3] = __uint_as_float(kv.y & 0xffff0000u);
                kf[4] = __uint_as_float(kv.z << 16); kf[5] = __uint_as_float(kv.z & 0xffff0000u); kf[6] = __uint_as_float(kv.w << 16); kf[7] = __uint_as_float(kv.w & 0xffff0000u);
#pragma unroll
                for (int g = 0; g < 4; ++g) { const f32x4 qa = *(const LAS f32x4*)(QS + g * 64 + d8 * 8), qb = *(const LAS f32x4*)(QS + g * 64 + d8 * 8 + 4);
                    const float d = (qa.x * kf[0] + qa.y * kf[1]) + (qa.z * kf[2] + qa.w * kf[3]) + (qb.x * kf[4] + qb.y * kf[5]) + (qb.z * kf[6] + qb.w * kf[7]);
                    if (g == 0) s0 += d; else if (g == 1) s1 += d; else if (g == 2) s2 += d; else s3 += d; } }
            if (!valid) { s0 = -1e30f; s1 = -1e30f; s2 = -1e30f; s3 = -1e30f; }
            m0 = fmaxf(m0, s0); m1 = fmaxf(m1, s1); m2 = fmaxf(m2, s2); m3 = fmaxf(m3, s3);
            *(LAS f32x4*)(PS + j * 4) = (f32x4){s0, s1, s2, s3}; }
        m0 = wave_max(m0); m1 = wave_max(m1); m2 = wave_max(m2); m3 = wave_max(m3);
        float l0 = 0.f, l1 = 0.f, l2 = 0.f, l3 = 0.f;
#pragma unroll 1
        for (int ps = 0; ps < 7; ++ps) { const int j = ps * 64 + lane; f32x4 sv = *(const LAS f32x4*)(PS + j * 4);
            sv.x = __expf(sv.x - m0); sv.y = __expf(sv.y - m1); sv.z = __expf(sv.z - m2); sv.w = __expf(sv.w - m3);
            l0 += sv.x; l1 += sv.y; l2 += sv.z; l3 += sv.w; *(LAS f32x4*)(PS + j * 4) = sv; }
        float linv[4]; linv[0] = 1.0f / wave_sum(l0); linv[1] = 1.0f / wave_sum(l1); linv[2] = 1.0f / wave_sum(l2); linv[3] = 1.0f / wave_sum(l3);
        LDS_WAIT();
        float o0 = 0.f, o1 = 0.f, o2 = 0.f, o3 = 0.f;
        for (int br = 0; br < 3; ++br) { const int sh = 2 * br; int nk = (t >> sh) + 1; nk = nk > 129 ? 129 : nk;
            const bf16* vbase = PROJ + seq0 * NPROJ + 640 + kvh * 64 + lane;
#pragma unroll 4
            for (int jj = 0; jj < nk; ++jj) { const int kpos = t - (jj << sh); const float v = bf2f(vbase[(size_t)kpos * NPROJ]); const f32x4 p4 = *(const LAS f32x4*)(PS + (br * 129 + jj) * 4);
                o0 += p4.x * v; o1 += p4.y * v; o2 += p4.z * v; o3 += p4.w * v; } }
        bf16* op = MIX + (size_t)tok * MIXW + kvh * 256 + lane;
        op[0] = (bf16)f2bf(o0 * linv[0]); op[64] = (bf16)f2bf(o1 * linv[1]); op[128] = (bf16)f2bf(o2 * linv[2]); op[192] = (bf16)f2bf(o3 * linv[3]);
        LDS_WAIT();
    }
}

__device__ __forceinline__ void phase_fixup(ArgsP a, int layer, int wave, int lane) {
    unsigned char* ws = a->ws; bf16* MIX = (bf16*)(ws + WS_MIX); const float* SSQ = (const float*)(ws + WS_SSQ); const float* w = a->in[9] + (size_t)layer * 1024;
    const int gw = blockIdx.x * 8 + wave, NGW = gridDim.x * 8;
    for (int row = gw; row < NTOK; row += NGW) { const int g = lane >> 5;
        const f32x4 q0 = *(const f32x4*)(SSQ + (size_t)row * 16 + 8 * g), q1 = *(const f32x4*)(SSQ + (size_t)row * 16 + 8 * g + 4);
        const float ssq = ((q0.x + q0.y) + (q0.z + q0.w)) + ((q1.x + q1.y) + (q1.z + q1.w)); const float rstd = 1.0f / sqrtf(ssq * (1.f / 512.f) + 1e-5f);
        u32x4* mp = (u32x4*)(MIX + (size_t)row * MIXW + 512 + lane * 16); const f32x4* wp = (const f32x4*)(w + lane * 16);
#pragma unroll
        for (int hlf = 0; hlf < 2; ++hlf) { u32x4 v = mp[hlf]; const f32x4 wa = wp[2 * hlf], wb = wp[2 * hlf + 1]; u32x4 o;
            o.x = pk2(__uint_as_float(v.x << 16) * rstd * wa.x, __uint_as_float(v.x & 0xffff0000u) * rstd * wa.y);
            o.y = pk2(__uint_as_float(v.y << 16) * rstd * wa.z, __uint_as_float(v.y & 0xffff0000u) * rstd * wa.w);
            o.z = pk2(__uint_as_float(v.z << 16) * rstd * wb.x, __uint_as_float(v.z & 0xffff0000u) * rstd * wb.y);
            o.w = pk2(__uint_as_float(v.w << 16) * rstd * wb.z, __uint_as_float(v.w & 0xffff0000u) * rstd * wb.w);
            mp[hlf] = o; } }
}

__global__ void __launch_bounds__(512, 2) fwd_kernel(Args a_by_value) {
    extern __shared__ __attribute__((aligned(16))) unsigned char lds_raw[];
    LAS unsigned char* lds = (LAS unsigned char*)lds_raw;
    ArgsP a0 = (ArgsP)__builtin_amdgcn_kernarg_segment_ptr();
    cg::grid_group grid = cg::this_grid();
    const int G = gridDim.x;
    const int ph_lo = a0->ph_lo, ph_hi = a0->ph_hi;
    for (int ph = ph_lo; ph < ph_hi; ++ph) {
        ArgsP a = a0; asm volatile("" : "+s"(a));
        unsigned char* ws = a->ws;
        int tid = threadIdx.x; asm volatile("" : "+v"(tid));
        const int lane = tid & 63, wave = __builtin_amdgcn_readfirstlane(tid >> 6);
        if (ph == 0) { if (PHM & 1) phase_prologue(a, lds, wave, lane); }
        else {
            const int l = (ph - 1) >> 3, s = (ph - 1) & 7;
            if (s == 0 && (PHM & 2)) {
                pg8::Gemm g{(const pg8::bf16_t*)(ws + WS_XN), (const pg8::bf16_t*)(ws + WS_WIN) + (size_t)l * NPROJ_PAD * DM, NTOK, NPROJ_PAD, DM};
                pg8::StaticOrder S; S.init(NTOK, NPROJ_PAD, G, (int)blockIdx.x);
                pg8::EpiInProj E{(pg8::bf16_t*)(ws + WS_PROJ), (float*)(ws + WS_DT), (const float*)(ws + WS_CS), a->in[6] + l * 16};
                pg8::gemm_phase<pg8::EpiInProj, pg8::StaticOrder>(lds, g, S, E, nullptr);
            } else if (s == 1) {
                if (PHM & 4) ssd_valu(a, l, lds, tid, lane);
                if (PHM & 8) attn_valu(a, lds, wave, lane);
            } else if (s == 2 && (PHM & 16)) {
                phase_fixup(a, l, wave, lane);
            } else if (s == 3 && (PHM & 32)) {
                pg8::Gemm g{(const pg8::bf16_t*)(ws + WS_MIX), (const pg8::bf16_t*)(ws + WS_WOUT) + (size_t)l * DM * MIXW, NTOK, DM, MIXW};
                pg8::StaticOrder S; S.init(NTOK, DM, G, (int)blockIdx.x);
                pg8::EpiRes E{l == 0 ? a->in[0] : a->out, a->out, DM};
                pg8::gemm_phase<pg8::EpiRes, pg8::StaticOrder>(lds, g, S, E, nullptr);
            } else if ((s == 4 || s == 7) && (PHM & 64)) {
                const int gw = blockIdx.x * 8 + wave, NGW = G * 8;
                if (s == 7 && l == 1) { for (int m = gw; m < NTOK; m += NGW) rms_row<true>(a->out + (size_t)m * DM, a->in[15], a->out + (size_t)m * DM, lane); }
                else { const float* w = s == 4 ? a->in[11] + (size_t)l * DM : a->in[2] + (size_t)(l + 1) * DM;
                    for (int m = gw; m < NTOK; m += NGW) rms_row<false>(a->out + (size_t)m * DM, w, (bf16*)(ws + WS_XN) + (size_t)m * DM, lane); }
            } else if (s == 5 && (PHM & 128)) {
                pg8::Gemm g{(const pg8::bf16_t*)(ws + WS_XN), (const pg8::bf16_t*)(ws + WS_WGU) + (size_t)l * 2 * FFN * DM, NTOK, 2 * FFN, DM};
                pg8::StaticOrder S; S.init(NTOK, 2 * FFN, G, (int)blockIdx.x);
                pg8::EpiGateUp E{(pg8::bf16_t*)(ws + WS_PROJ)};
                pg8::gemm_phase<pg8::EpiGateUp, pg8::StaticOrder>(lds, g, S, E, nullptr);
            } else if (s == 6 && (PHM & 256)) {
                pg8::Gemm g{(const pg8::bf16_t*)(ws + WS_PROJ), (const pg8::bf16_t*)(ws + WS_WDN) + (size_t)l * DM * FFN, NTOK, DM, FFN};
                pg8::StaticOrder S; S.init(NTOK, DM, G, (int)blockIdx.x);
                pg8::EpiRes E{a->out, a->out, DM};
                pg8::gemm_phase<pg8::EpiRes, pg8::StaticOrder>(lds, g, S, E, nullptr);
            }
        }
        if (ph + 1 < ph_hi) grid.sync();
    }
}

extern "C" void kernel_launch(void* const* d_in, const int* in_sizes, int n_in, void* d_out, int out_size, void* d_ws, size_t ws_size, hipStream_t stream) {
    static int ready = 0;
    if (!ready) {
        if (n_in != 16 || out_size != NTOK * DM || ws_size < WS_END) { fprintf(stderr, "kernel_launch: unexpected shapes (n_in %d, out %d, ws %zu)\n", n_in, out_size, ws_size); ready = -1; return; }
        if (hipFuncSetAttribute((const void*)fwd_kernel, hipFuncAttributeMaxDynamicSharedMemorySize, LDS_BYTES) != hipSuccess) { fprintf(stderr, "kernel_launch: hipFuncSetAttribute failed\n"); ready = -1; return; }
        ready = 1;
    }
    if (ready < 0) return;
    Args a{};
    for (int i = 0; i < 16; ++i) a.in[i] = (const float*)d_in[i];
    a.out = (float*)d_out; a.ws = (unsigned char*)d_ws;
    for (int i = 0; i < 8; ++i) a.inv_freq[i] = (float)pow(500000.0, -(double)(2 * i) / 16.0);
#if ONE_LAUNCH
    a.ph_lo = 0; a.ph_hi = NPHASE;
    void* args[] = {&a};
    hipError_t e = hipLaunchCooperativeKernel((const void*)fwd_kernel, dim3(256), dim3(512), args, LDS_BYTES, stream);
    if (e != hipSuccess) fprintf(stderr, "cooperative launch failed: %s\n", hipGetErrorString(e));
#else
    for (int ph = 0; ph < NPHASE; ++ph) { a.ph_lo = ph; a.ph_hi = ph + 1; hipLaunchKernelGGL(fwd_kernel, dim3(256), dim3(512), LDS_BYTES, stream, a); }
#endif
}
```

```cpp
#include <hip/hip_runtime.h>
#include <hip/hip_cooperative_groups.h>
#include <cstdio>
#include <cmath>
namespace cg = cooperative_groups;
#ifndef PHM
#define PHM 511
#endif
#ifndef ONE_LAUNCH
#define ONE_LAUNCH 1
#endif
namespace pg8 {
#define PG8_LAS __attribute__((address_space(3)))
typedef unsigned short bf16_t;
typedef short bf16x8 __attribute__((ext_vector_type(8)));
typedef float f32x4 __attribute__((ext_vector_type(4)));
typedef unsigned u32x4 __attribute__((ext_vector_type(4)));
constexpr int BM = 256, BK = 64, HALF = 128, HTB = HALF * BK * 2  , STAGE_BYTES = 8 * HTB, NXCD = 8, WGM = 8;

__host__ __device__ __forceinline__ int lds_byte(int r, int c) { const int st = (r >> 4) * 2 + (c >> 5), rr = r & 15, cc = c & 31, ob = rr * 64 + cc * 2; return st * 1024 + (ob ^ (((ob >> 9) & 1) << 5)); }
__host__ __device__ __forceinline__ void stage_rc(int b, int& R, int& C) { const int st = b / 1024, sb = b % 1024, swz = sb ^ (((sb >> 9) & 1) << 5); R = (st >> 1) * 16 + swz / 64; C = (st & 1) * 32 + (swz % 64) / 2; }
__host__ __device__ __forceinline__ int perm32(int rho) { const int n = rho >> 4, i = rho & 15; return 8 * (i >> 2) + 4 * n + (i & 3); }

struct Unit { int pm, pn; };
struct Gemm { const bf16_t* A; const bf16_t* Bt; int M, N, K; };

struct StaticOrder {
    int nM, nN, nwg, G, c;
    __host__ __device__ void init(int M, int N, int G_, int c_) { nM = M / BM; nN = N / BM; nwg = nM * nN; G = G_; c = c_; }
    __host__ __device__ bool next(int i, Unit& u) const {
        const long L = (long)i * G + c; if (L >= nwg) return false;
        int wgid = (int)L; { const int q = nwg / NXCD, r = nwg % NXCD, xcd = wgid % NXCD, off = wgid / NXCD; wgid = (xcd < r ? xcd * (q + 1) : r * (q + 1) + (xcd - r) * q) + off; }
        const int nig = WGM * nN, gid = wgid / nig, fm = gid * WGM, gsz = (nM - fm) < WGM ? (nM - fm) : WGM;
        u.pm = fm + ((wgid % nig) % gsz); u.pn = (wgid % nig) / gsz; return true;
    }
    __device__ __forceinline__ void a_ready(const Unit&) const {}
    __device__ __forceinline__ void done(const Unit&) const {}
};
__device__ __forceinline__ unsigned cvt_pk_bf16(float lo, float hi) { unsigned r; asm volatile("v_cvt_pk_bf16_f32 %0, %1, %2" : "=v"(r) : "v"(lo), "v"(hi)); return r; }
typedef float f32x2 __attribute__((ext_vector_type(2)));
template <class Epi, class Sched, bool STAMP = false>
__device__ __forceinline__ void gemm_phase(PG8_LAS unsigned char* lds, const Gemm g, const Sched& S, const Epi& E, unsigned long long* stamps) {
    int tid_ = threadIdx.x; asm volatile("" : "+v"(tid_));
    const int tid = tid_, wid = __builtin_amdgcn_readfirstlane(tid >> 6), lane = tid & 63, wr = wid >> 2, wc = wid & 3, fr = lane & 15, fq = lane >> 4;
    const int K = g.K, nt = K / BK;
    int ts_lo = 0, ts_hi = 0, nts = 0; const unsigned long long rt_entry = STAMP ? (unsigned long long)wall_clock64() : 0ull;
#define PG8_STAMP() do { if (STAMP && wid == 0 && nts < 64) { const unsigned long long _c = (unsigned long long)clock64(); \
        ts_lo = (lane == nts) ? (int)(unsigned)_c : ts_lo; ts_hi = (lane == nts) ? (int)(unsigned)(_c >> 32) : ts_hi; ++nts; } } while (0)
    PG8_STAMP();
    unsigned voffA[2], voffB[2];
#pragma unroll
    for (int i = 0; i < 2; ++i) { int R, C; stage_rc(tid * 16 + i * 8192, R, C); const int Rb = Epi::PERM ? ((R & ~31) + perm32(R & 31)) : R;
        voffA[i] = (unsigned)(R * K + C) * 2u; voffB[i] = (unsigned)(Rb * K + C) * 2u; }
    const size_t kstep = (size_t)(BK * 2);
    const size_t hstep = (size_t)HALF * K * 2;
    const size_t tstep = 2 * hstep;
    const unsigned ldsw = (unsigned)wid * 1024u;
    const int aoff = lds_byte(wr * 64 + fr, fq * 8), boff = lds_byte(wc * 32 + fr, fq * 8);
#define PG8_SA(b, h) (((b) * 2 + (h)) * HTB)
#define PG8_SB(b, h) ((4 + (b) * 2 + (h)) * HTB)
#define PG8_STAGE(bufoff, gbase, voff) do { _Pragma("unroll") for (int _i = 0; _i < 2; ++_i) \
        __builtin_amdgcn_global_load_lds((const unsigned*)((const char*)(gbase) + (voff)[_i]), (PG8_LAS unsigned*)(lds + (bufoff) + ldsw + _i * 8192), 16, 0, 0); } while (0)
#define PG8_LDA(dst, b, h) do { _Pragma("unroll") for (int m = 0; m < 4; ++m) _Pragma("unroll") for (int k = 0; k < 2; ++k) dst[m][k] = *(const PG8_LAS bf16x8*)(lds + PG8_SA(b, h) + aoff + m * 2048 + k * 1024); } while (0)
#define PG8_LDB(dst, b, h) do { _Pragma("unroll") for (int n = 0; n < 2; ++n) _Pragma("unroll") for (int k = 0; k < 2; ++k) dst[n][k] = *(const PG8_LAS bf16x8*)(lds + PG8_SB(b, h) + boff + n * 2048 + k * 1024); } while (0)
#define PG8_MMA(ai, bj, At, Bt) do { __builtin_amdgcn_s_setprio(1); _Pragma("unroll") for (int m = 0; m < 4; ++m) _Pragma("unroll") for (int n = 0; n < 2; ++n) _Pragma("unroll") for (int k = 0; k < 2; ++k) \
        acc[ai][bj][m][n] = __builtin_amdgcn_mfma_f32_16x16x32_bf16(Bt[n][k], At[m][k], acc[ai][bj][m][n], 0, 0, 0); __builtin_amdgcn_s_setprio(0); } while (0)
#define PG8_WAIT_V(n) asm volatile("s_waitcnt vmcnt(" #n ")" ::: "memory")
#define PG8_WAIT_L(n) asm volatile("s_waitcnt lgkmcnt(" #n ")" ::: "memory")
#define PG8_BAR __builtin_amdgcn_s_barrier()
#define PG8_SCHED __builtin_amdgcn_sched_barrier(0)
    Unit cur, nxt; int ui = 0;
    if (!S.next(0, cur)) return;
    f32x4 acc[2][2][4][2];
#pragma unroll
    for (int a = 0; a < 2; ++a)
#pragma unroll
        for (int b = 0; b < 2; ++b)
#pragma unroll
            for (int m = 0; m < 4; ++m)
#pragma unroll
                for (int n = 0; n < 2; ++n) acc[a][b][m][n] = (f32x4){0.f, 0.f, 0.f, 0.f};
    bf16x8 At[4][2], B0[2][2], B1[2][2];
    const char* cA = (const char*)g.A + (size_t)cur.pm * tstep; const char* cB = (const char*)g.Bt + (size_t)cur.pn * tstep;
    S.a_ready(cur);
    PG8_STAGE(PG8_SB(0, 0), cB, voffB); PG8_STAGE(PG8_SA(0, 0), cA, voffA); PG8_STAGE(PG8_SB(0, 1), cB + hstep, voffB); PG8_STAGE(PG8_SA(0, 1), cA + hstep, voffA);
    if (wr == 1) PG8_BAR;
    PG8_WAIT_V(4); PG8_BAR;
    PG8_STAGE(PG8_SB(1, 0), cB + kstep, voffB); PG8_STAGE(PG8_SA(1, 0), cA + kstep, voffA); PG8_STAGE(PG8_SB(1, 1), cB + hstep + kstep, voffB);
    PG8_WAIT_V(6); PG8_BAR;
    PG8_STAMP();
    for (;;) {
        const bool has_next = S.next(ui + 1, nxt);
        const char* nA = has_next ? (const char*)g.A + (size_t)nxt.pm * tstep : cA; const char* nB = has_next ? (const char*)g.Bt + (size_t)nxt.pn * tstep : cB;
        for (int t = 0; t < nt; t += 2) {
            const bool last = (t == nt - 2);
            const char* a1 = cA + (size_t)(t + 1) * kstep;
            const char* a2 = last ? nA : cA + (size_t)(t + 2) * kstep; const char* b2 = last ? nB : cB + (size_t)(t + 2) * kstep;
            const char* a3 = a2 + kstep; const char* b3 = b2 + kstep;
            if (last && has_next) S.a_ready(nxt);
            PG8_LDB(B0, 0, 0); PG8_SCHED; PG8_LDA(At, 0, 0); PG8_STAGE(PG8_SA(1, 1), a1 + hstep, voffA);
            PG8_WAIT_L(8); PG8_BAR; PG8_WAIT_L(0); PG8_MMA(0, 0, At, B0); PG8_BAR; PG8_SCHED;
            PG8_LDB(B1, 0, 1); PG8_STAGE(PG8_SB(0, 0), b2, voffB);
            PG8_BAR; PG8_WAIT_L(0); PG8_MMA(0, 1, At, B1); PG8_BAR;
            PG8_LDA(At, 0, 1); PG8_STAGE(PG8_SA(0, 0), a2, voffA);
            PG8_BAR; PG8_WAIT_L(0); PG8_MMA(1, 0, At, B0); PG8_BAR; PG8_SCHED;
            PG8_STAGE(PG8_SB(0, 1), b2 + hstep, voffB);
            PG8_WAIT_V(6); PG8_BAR; PG8_MMA(1, 1, At, B1); PG8_BAR;
            PG8_LDB(B0, 1, 0); PG8_SCHED; PG8_LDA(At, 1, 0); PG8_STAGE(PG8_SA(0, 1), a2 + hstep, voffA);
            PG8_WAIT_L(8); PG8_BAR; PG8_WAIT_L(0); PG8_MMA(0, 0, At, B0); PG8_BAR; PG8_SCHED;
            PG8_LDB(B1, 1, 1); PG8_STAGE(PG8_SB(1, 0), b3, voffB);
            PG8_BAR; PG8_WAIT_L(0); PG8_MMA(0, 1, At, B1); PG8_BAR;
            PG8_LDA(At, 1, 1); PG8_STAGE(PG8_SA(1, 0), a3, voffA);
            PG8_BAR; PG8_WAIT_L(0); PG8_MMA(1, 0, At, B0); PG8_BAR; PG8_SCHED;
            PG8_STAGE(PG8_SB(1, 1), b3 + hstep, voffB);
            PG8_WAIT_V(6); PG8_BAR; PG8_MMA(1, 1, At, B1); PG8_BAR;
        }
        PG8_STAMP();
        if constexpr (!Epi::AFTER_DRAIN) { E(acc, cur, wr, wc, fr, fq); S.done(cur); }
        PG8_STAMP();
        if (!has_next) break;
#pragma unroll
        for (int a = 0; a < 2; ++a)
#pragma unroll
            for (int b = 0; b < 2; ++b)
#pragma unroll
                for (int m = 0; m < 4; ++m)
#pragma unroll
                    for (int n = 0; n < 2; ++n) acc[a][b][m][n] = (f32x4){0.f, 0.f, 0.f, 0.f};
        cur = nxt; cA = nA; cB = nB; ++ui;
    }
    PG8_WAIT_V(0);
    if (wr == 0) PG8_BAR;
    PG8_BAR;
    if constexpr (Epi::AFTER_DRAIN) { E.fused(acc, cur, wr, wc, fr, fq, lds, wid, lane); S.done(cur); }
    PG8_STAMP();
    if (STAMP && wid == 0) { stamps[lane] = lane < nts ? (((unsigned long long)(unsigned)ts_hi << 32) | (unsigned)ts_lo) : 0ull;
        if (lane == 62) stamps[62] = rt_entry; if (lane == 63) stamps[63] = (unsigned long long)wall_clock64(); }
#undef PG8_STAMP
#undef PG8_SA
#undef PG8_SB
#undef PG8_STAGE
#undef PG8_LDA
#undef PG8_LDB
#undef PG8_MMA
#undef PG8_WAIT_V
#undef PG8_WAIT_L
#undef PG8_BAR
#undef PG8_SCHED
}
}

namespace pg8 {
__device__ __forceinline__ float silu_f(float x) { return x * __builtin_amdgcn_rcpf(1.0f + __expf(-x)); }

struct EpiInProj {
    static constexpr bool PERM = true, AFTER_DRAIN = false;
    bf16_t* P; float* DT; const float* CS; const float* dt_bias; const float* SSP;
    __device__ __forceinline__ float row_rstd(int row) const { return 1.0f / sqrtf(SSP[row] * (1.f / 1024.f) + 1e-5f); }
    __device__ __forceinline__ void operator()(const f32x4 (&acc)[2][2][4][2], const Unit& u, int wr, int wc, int fr, int fq) const {
        const int row0 = u.pm * BM + wr * 64 + fr; const int pn = u.pn;
        float rsv[2][4];
#pragma unroll
        for (int ai = 0; ai < 2; ++ai)
#pragma unroll
            for (int m = 0; m < 4; ++m) rsv[ai][m] = SSP[row0 + ai * HALF + m * 16];
        if (pn == 13) {
            if (wc == 0 && fq < 2) {
                const f32x4 b0 = *(const f32x4*)(dt_bias + 8 * fq), b1 = *(const f32x4*)(dt_bias + 8 * fq + 4);
#pragma unroll
                for (int ai = 0; ai < 2; ++ai)
#pragma unroll
                    for (int m = 0; m < 4; ++m) { const int row = row0 + ai * HALF + m * 16;
                        const float rs = 1.0f / sqrtf(rsv[ai][m] * (1.f / 1024.f) + 1e-5f); f32x4 v0 = acc[ai][0][m][0] * rs + b0, v1 = acc[ai][0][m][1] * rs + b1;
#pragma unroll
                        for (int e = 0; e < 4; ++e) { v0[e] = v0[e] > 20.f ? v0[e] : fmaxf(log1pf(__expf(v0[e])), 1e-30f); v1[e] = v1[e] > 20.f ? v1[e] : fmaxf(log1pf(__expf(v1[e])), 1e-30f); }
                        *(f32x4*)(DT + (size_t)row * 16 + 8 * fq) = v0; *(f32x4*)(DT + (size_t)row * 16 + 8 * fq + 4) = v1; }
            }
            return;
        }
        const bool rot_wave = (pn < 3) && ((wc & 1) == 0);
#pragma unroll
        for (int ai = 0; ai < 2; ++ai)
#pragma unroll
          for (int mb = 0; mb < 4; mb += 2) {
            f32x4 csv[2][4];
#pragma unroll
            for (int mi = 0; mi < 2; ++mi)
#pragma unroll
                for (int i = 0; i < 4; ++i) csv[mi][i] = (i < 2) ? (f32x4){1.f, 1.f, 1.f, 1.f} : (f32x4){0.f, 0.f, 0.f, 0.f};
            if (rot_wave) {
#pragma unroll
                for (int mi = 0; mi < 2; ++mi) { const float* cs = CS + (size_t)(row0 + ai * HALF + (mb + mi) * 16) * 16;
#pragma unroll
                    for (int i = 0; i < 4; ++i) csv[mi][i] = *(const f32x4*)(cs + 4 * i); } }
#pragma unroll
            for (int mi = 0; mi < 2; ++mi) { const int m = mb + mi; const int row = row0 + ai * HALF + m * 16;
                const f32x4 c0 = csv[mi][0], c1 = csv[mi][1], s0 = csv[mi][2], s1 = csv[mi][3];
                bf16_t* rowp = P + (size_t)row * 3328 + pn * 256 + wc * 32 + 8 * fq; const float rs = 1.0f / sqrtf(rsv[ai][m] * (1.f / 1024.f) + 1e-5f);
#pragma unroll
                for (int bj = 0; bj < 2; ++bj) { f32x4 v0 = acc[ai][bj][m][0] * rs, v1 = acc[ai][bj][m][1] * rs;
                    const bool rope = rot_wave && (pn < 2 || bj == 0);
                    if (rope) { f32x4 p0, p1;
#pragma unroll
                        for (int e = 0; e < 4; ++e) { p0[e] = __shfl_xor(v0[e], 16); p1[e] = __shfl_xor(v1[e], 16); }
                        if (fq < 2) { const float sg = fq == 0 ? -1.f : 1.f; v0 = v0 * c0 + sg * (p0 * s0); v1 = v1 * c1 + sg * (p1 * s1); } }
                    if (pn < 2) { v0 = v0 * 0.18033688011112042f; v1 = v1 * 0.18033688011112042f; }
                    u32x4 w; w.x = cvt_pk_bf16(v0[0], v0[1]); w.y = cvt_pk_bf16(v0[2], v0[3]); w.z = cvt_pk_bf16(v1[0], v1[1]); w.w = cvt_pk_bf16(v1[2], v1[3]);
                    *(u32x4*)(rowp + bj * HALF) = w; } } }
    }
};
struct EpiRes {
    static constexpr bool PERM = true, AFTER_DRAIN = false;
    bf16_t* hb; float* ssp;
    __device__ __forceinline__ void operator()(const f32x4 (&acc)[2][2][4][2], const Unit& u, int wr, int wc, int fr, int fq) const {
        const int row0 = u.pm * BM + wr * 64 + fr, col0 = u.pn * BM + wc * 32 + 8 * fq;
        u32x4 bwv[2][4][2];
#pragma unroll
        for (int ai = 0; ai < 2; ++ai)
#pragma unroll
            for (int m = 0; m < 4; ++m) { const bf16_t* hp = hb + (size_t)(row0 + ai * HALF + m * 16) * 1024 + col0; bwv[ai][m][0] = *(const u32x4*)(hp); bwv[ai][m][1] = *(const u32x4*)(hp + HALF); }
#pragma unroll
        for (int ai = 0; ai < 2; ++ai) {
#pragma unroll
            for (int m = 0; m < 4; ++m) { const int row = row0 + ai * HALF + m * 16; bf16_t* hp = hb + (size_t)row * 1024 + col0; float ss = 0.f;
                const u32x4 bw0 = bwv[ai][m][0], bw1 = bwv[ai][m][1];
#pragma unroll
                for (int bj = 0; bj < 2; ++bj) { const u32x4 bw = bj ? bw1 : bw0;
                    f32x4 v0 = acc[ai][bj][m][0], v1 = acc[ai][bj][m][1];
                    v0[0] += __uint_as_float(bw.x << 16); v0[1] += __uint_as_float(bw.x & 0xffff0000u); v0[2] += __uint_as_float(bw.y << 16); v0[3] += __uint_as_float(bw.y & 0xffff0000u);
                    v1[0] += __uint_as_float(bw.z << 16); v1[1] += __uint_as_float(bw.z & 0xffff0000u); v1[2] += __uint_as_float(bw.w << 16); v1[3] += __uint_as_float(bw.w & 0xffff0000u);
                    ss += ((v0[0] * v0[0] + v0[1] * v0[1]) + (v0[2] * v0[2] + v0[3] * v0[3])) + ((v1[0] * v1[0] + v1[1] * v1[1]) + (v1[2] * v1[2] + v1[3] * v1[3]));
                    u32x4 w; w.x = cvt_pk_bf16(v0[0], v0[1]); w.y = cvt_pk_bf16(v0[2], v0[3]); w.z = cvt_pk_bf16(v1[0], v1[1]); w.w = cvt_pk_bf16(v1[2], v1[3]); *(u32x4*)(hp + bj * HALF) = w; }
                ss += __shfl_xor(ss, 16); ss += __shfl_xor(ss, 32);
                if (fq == 0) __hip_atomic_fetch_add(ssp + row, ss, __ATOMIC_RELAXED, __HIP_MEMORY_SCOPE_AGENT); } }
    }
};
struct EpiGateUp {
    static constexpr bool PERM = true, AFTER_DRAIN = false;
    bf16_t* H; const float* SSP;
    __device__ __forceinline__ void operator()(const f32x4 (&acc)[2][2][4][2], const Unit& u, int wr, int wc, int fr, int fq) const {
        const int row0 = u.pm * BM + wr * 64 + fr, col0 = u.pn * HALF + wc * 32 + 8 * fq;
        float rsv[2][4];
#pragma unroll
        for (int ai = 0; ai < 2; ++ai)
#pragma unroll
            for (int m = 0; m < 4; ++m) rsv[ai][m] = SSP[row0 + ai * HALF + m * 16];
#pragma unroll
        for (int ai = 0; ai < 2; ++ai)
#pragma unroll
            for (int m = 0; m < 4; ++m) { const float rs = 1.0f / sqrtf(rsv[ai][m] * (1.f / 1024.f) + 1e-5f);
                const f32x4 g0 = acc[ai][0][m][0] * rs, g1 = acc[ai][0][m][1] * rs, u0 = acc[ai][1][m][0] * rs, u1 = acc[ai][1][m][1] * rs; f32x4 h0, h1;
#pragma unroll
                for (int e = 0; e < 4; ++e) { h0[e] = silu_f(g0[e]) * u0[e]; h1[e] = silu_f(g1[e]) * u1[e]; }
                u32x4 w; w.x = cvt_pk_bf16(h0[0], h0[1]); w.y = cvt_pk_bf16(h0[2], h0[3]); w.z = cvt_pk_bf16(h1[0], h1[1]); w.w = cvt_pk_bf16(h1[2], h1[3]);
                *(u32x4*)(H + (size_t)(row0 + ai * HALF + m * 16) * 2816 + col0) = w; }
    }
};
}

#define LAS __attribute__((address_space(3)))
typedef unsigned short bf16;
typedef float f32x4 __attribute__((ext_vector_type(4)));
typedef unsigned u32x4 __attribute__((ext_vector_type(4)));
typedef unsigned u32x2 __attribute__((ext_vector_type(2)));

constexpr int NTOK = 65536, DM = 1024, SEQ = 2048;
constexpr int NPROJ = 3328, NPROJ_PAD = 3584, NPROJ_SRC = 3344, MIXW = 1536, FFN = 2816, CONVCH = 1536;
constexpr size_t MiB = 1u << 20;
constexpr size_t WS_WIN = 1 * MiB, WS_WOUT = 15 * MiB, WS_WGU = 21 * MiB, WS_WDN = 43 * MiB, WS_CS = 54 * MiB, WS_DT = 58 * MiB, WS_SSQ = 808 * MiB,
                 WS_XN = 66 * MiB, WS_PROJ = 194 * MiB, WS_MIX = 610 * MiB, WS_LSE = 802 * MiB, WS_SSP = 824 * MiB, WS_CBC = 844 * MiB, WS_END = 908 * MiB;
constexpr int LDS_BYTES = 147456;
constexpr int NPHASE = 14;

__device__ __forceinline__ float bf2f(unsigned short b) { return __uint_as_float(((unsigned)b) << 16); }
__device__ __forceinline__ unsigned f2bf(float f) { unsigned u = __float_as_uint(f); return (u + 0x7fffu + ((u >> 16) & 1u)) >> 16; }
__device__ __forceinline__ unsigned pk2(float lo, float hi) { return f2bf(lo) | (f2bf(hi) << 16); }
__device__ __forceinline__ float silu(float x) { return x * __builtin_amdgcn_rcpf(1.0f + __expf(-x)); }
__device__ __forceinline__ float wave_sum(float v) {
#pragma unroll
    for (int o = 1; o < 64; o <<= 1) v += __shfl_xor(v, o);
    return v;
}
__device__ __forceinline__ float wave_max(float v) {
#pragma unroll
    for (int o = 1; o < 64; o <<= 1) v = fmaxf(v, __shfl_xor(v, o));
    return v;
}
#define LDS_WAIT() asm volatile("s_waitcnt lgkmcnt(0)" ::: "memory")

struct Args { const float* in[16]; float* out; unsigned char* ws; float inv_freq[8]; int ph_lo, ph_hi; };
typedef const __attribute__((address_space(4))) Args* ArgsP;

__device__ __forceinline__ void transpose_item(const float* W, int Nsrc, int K, bf16* WT, int k0, int n0, int drow0, LAS float* scr, int lane, const float* kscale) {
#pragma unroll 8
    for (int i = 0; i < 32; ++i) { const int kk = 2 * i + (lane >> 5), n = n0 + (lane & 31); const float sc = kscale ? kscale[k0 + kk] : 1.0f; scr[kk * 33 + (lane & 31)] = n < Nsrc ? W[(size_t)(k0 + kk) * Nsrc + n] * sc : 0.f; }
    LDS_WAIT();
    const int c = lane & 7;
#pragma unroll
    for (int j = 0; j < 4; ++j) { const int nn = (lane >> 3) + 8 * j; const LAS float* s = scr + (8 * c) * 33 + nn;
        u32x4 o; o.x = pk2(s[0 * 33], s[1 * 33]); o.y = pk2(s[2 * 33], s[3 * 33]); o.z = pk2(s[4 * 33], s[5 * 33]); o.w = pk2(s[6 * 33], s[7 * 33]);
        *(u32x4*)(WT + (size_t)(drow0 + nn) * K + k0 + 8 * c) = o; }
    LDS_WAIT();
}

template <bool TOF32>
__device__ __forceinline__ void rms_row(const float* xrow, const float* w, void* orow, int lane) {
    const f32x4* xr = (const f32x4*)xrow + lane; const f32x4* wr = (const f32x4*)w + lane;
    f32x4 v[4]; float s = 0.f;
#pragma unroll
    for (int j = 0; j < 4; ++j) { v[j] = xr[64 * j]; s += (v[j].x * v[j].x + v[j].y * v[j].y) + (v[j].z * v[j].z + v[j].w * v[j].w); }
    const float rstd = 1.0f / sqrtf(wave_sum(s) * (1.f / 1024.f) + 1e-5f);
#pragma unroll
    for (int j = 0; j < 4; ++j) { const f32x4 ww = wr[64 * j]; const f32x4 o = v[j] * rstd * ww;
        if (TOF32) ((f32x4*)orow)[lane + 64 * j] = o;
        else { u32x2 pk; pk.x = pk2(o.x, o.y); pk.y = pk2(o.z, o.w); ((u32x2*)orow)[lane + 64 * j] = pk; } }
}

__device__ __forceinline__ void phase_prologue(ArgsP a, LAS unsigned char* lds, int wave, int lane) {
    unsigned char* ws = a->ws;
    LAS float* scr = (LAS float*)(lds + wave * 16384);
    const int gw = blockIdx.x * 8 + wave, NGW = gridDim.x * 8;
    constexpr int I_IN = 16 * 112, I_OUT = 24 * 32, I_G = 16 * 88, I_D = 44 * 32, I_LAYER = I_IN + I_OUT + 2 * I_G + I_D;
    for (int it = gw; it < 2 * I_LAYER; it += NGW) {
        const int l = it / I_LAYER; int r = it - l * I_LAYER;
        if (r < I_IN) { const int kb = r / 112, nb = r % 112; transpose_item(a->in[3] + (size_t)l * DM * NPROJ_SRC, NPROJ_SRC, DM, (bf16*)(ws + WS_WIN) + (size_t)l * NPROJ_PAD * DM, kb * 64, nb * 32, nb * 32, scr, lane, a->in[2] + (size_t)l * DM); continue; } r -= I_IN;
        if (r < I_OUT) { const int kb = r / 32, nb = r % 32; transpose_item(a->in[10] + (size_t)l * MIXW * DM, DM, MIXW, (bf16*)(ws + WS_WOUT) + (size_t)l * DM * MIXW, kb * 64, nb * 32, nb * 32, scr, lane, nullptr); continue; } r -= I_OUT;
        if (r < 2 * I_G) { const int s = r / I_G; r -= s * I_G; const int kb = r / 88, nb = r % 88, n0 = nb * 32;
            transpose_item((s ? a->in[13] : a->in[12]) + (size_t)l * DM * FFN, FFN, DM, (bf16*)(ws + WS_WGU) + (size_t)l * 2 * FFN * DM, kb * 64, n0, 256 * (n0 >> 7) + 128 * s + (n0 & 127), scr, lane, a->in[11] + (size_t)l * DM); continue; } r -= 2 * I_G;
        { const int kb = r / 32, nb = r % 32; transpose_item(a->in[14] + (size_t)l * FFN * DM, DM, FFN, (bf16*)(ws + WS_WDN) + (size_t)l * DM * FFN, kb * 64, nb * 32, nb * 32, scr, lane, nullptr); }
    }
    const int* pos = (const int*)a->in[1]; float* CS = (float*)(ws + WS_CS);
    for (int idx = gw * 64 + lane; idx < NTOK * 8; idx += NGW * 64) { const int row = idx >> 3, i = idx & 7;
        const float fr_ = i == 0 ? a->inv_freq[0] : i == 1 ? a->inv_freq[1] : i == 2 ? a->inv_freq[2] : i == 3 ? a->inv_freq[3] : i == 4 ? a->inv_freq[4] : i == 5 ? a->inv_freq[5] : i == 6 ? a->inv_freq[6] : a->inv_freq[7];
        const float ang = (float)pos[row] * fr_; const double ad = (double)ang; const double k = rint(ad * 0.15915494309189535); const float r = (float)(ad - k * 6.283185307179586);
        CS[(size_t)row * 16 + i] = __cosf(r); CS[(size_t)row * 16 + 8 + i] = __sinf(r); }
    for (int k = 0; k < 32; k += 2) { const int m = (blockIdx.x & 7) * 8192 + (blockIdx.x >> 3) * 8 + wave + 256 * k;
        f32x4 va[4], vb[4]; const f32x4* xa = (const f32x4*)(a->in[0] + (size_t)m * DM) + lane; const f32x4* xb = (const f32x4*)(a->in[0] + (size_t)(m + 256) * DM) + lane;
#pragma unroll
        for (int j = 0; j < 4; ++j) { va[j] = xa[64 * j]; vb[j] = xb[64 * j]; }
#pragma unroll
        for (int h2 = 0; h2 < 2; ++h2) { const int mm = m + h2 * 256; u32x2* o8 = (u32x2*)((bf16*)(ws + WS_XN) + (size_t)mm * DM) + lane; float ss = 0.f;
#pragma unroll
            for (int j = 0; j < 4; ++j) { const f32x4 v = h2 ? vb[j] : va[j]; ss += (v.x * v.x + v.y * v.y) + (v.z * v.z + v.w * v.w); u32x2 pk; pk.x = pk2(v.x, v.y); pk.y = pk2(v.z, v.w); o8[64 * j] = pk; }
            ss = wave_sum(ss); if (lane < 5) ((float*)(ws + WS_SSP))[(size_t)lane * NTOK + mm] = lane == 0 ? ss : 0.f; } }
}

typedef short bf16x8 __attribute__((ext_vector_type(8)));
typedef short s16x4 __attribute__((ext_vector_type(4)));
typedef float f32x16 __attribute__((ext_vector_type(16)));
constexpr int KSTR = 72, VSTR = 96;
constexpr int ATT_UNITS = 32 * 2 * 48;

__device__ __forceinline__ void attn_decode(int U, int& b, int& kvh, int& br, int& sh, int& res, int& n) {
    const int bk = U / 48, u48 = U - bk * 48; b = bk >> 1; kvh = bk & 1; br = u48 >> 4; const int idx = u48 & 15; sh = 2 * br;
    res = br == 0 ? 0 : (br == 1 ? (idx & 3) : idx); n = br == 0 ? idx : (br == 1 ? (idx >> 2) : 0);
}
__device__ __forceinline__ void attn_prefetch(const bf16* PROJ, int U, int skey, int sdc, u32x4 (&kreg)[4], u32x4 (&vreg)[4]) {
    int b, kvh, br, sh, res, n; attn_decode(U, b, kvh, br, sh, res, n);
#pragma unroll
    for (int i = 0; i < 4; ++i) { const int l = 128 * (n - 1) + skey + 64 * i;
        if (l >= 0) { const int t = (l << sh) + res; const bf16* p = PROJ + (size_t)(b * SEQ + t) * NPROJ + kvh * 64 + sdc * 8; kreg[i] = *(const u32x4*)(p + 512); vreg[i] = *(const u32x4*)(p + 640); }
        else { kreg[i] = (u32x4){0u, 0u, 0u, 0u}; vreg[i] = (u32x4){0u, 0u, 0u, 0u}; } }
}
#define TR_READ8(dst, addr, OFF0, OFF1) do { s16x4 _a, _b; asm volatile("ds_read_b64_tr_b16 %0, %2 offset:%3\n\tds_read_b64_tr_b16 %1, %2 offset:%4\n\ts_waitcnt lgkmcnt(0)" : "=&v"(_a), "=&v"(_b) : "v"(addr), "i"(OFF0), "i"(OFF1) : "memory"); \
    dst = (bf16x8){_a[0], _a[1], _a[2], _a[3], _b[0], _b[1], _b[2], _b[3]}; } while (0)

__device__ __forceinline__ void attn_mfma(ArgsP a, LAS unsigned char* lds, int tid, int wave, int lane) {
    unsigned char* ws = a->ws;
    const bf16* PROJ = (const bf16*)(ws + WS_PROJ); bf16* OA = (bf16*)a->out; bf16* OB = OA + (size_t)NTOK * 512; bf16* MIX = (bf16*)(ws + WS_MIX); float* LSE = (float*)(ws + WS_LSE);
    LAS bf16* KS = (LAS bf16*)lds; LAS bf16* VS = KS + 256 * KSTR;
    const int g = wave >> 1, qh = wave & 1, r = lane & 31, hh = lane >> 5;
    const int skey = tid >> 3, sdc = tid & 7;
    const unsigned vs_lane = (unsigned)(size_t)VS + (unsigned)((4 * hh + ((lane & 15) >> 2)) * (VSTR * 2) + (16 * ((lane >> 4) & 1) + 4 * (lane & 3)) * 2);
    u32x4 kreg[4], vreg[4];
    const int ubase = (blockIdx.x & 7) * (ATT_UNITS / 8) + (blockIdx.x >> 3);
    attn_prefetch(PROJ, ubase, skey, sdc, kreg, vreg);
    for (int ui = 0; ui < ATT_UNITS / 256; ++ui) { const int U = ubase + 32 * ui;
        int b, kvh, br, sh, res, n; attn_decode(U, b, kvh, br, sh, res, n);
        const int head = kvh * 4 + g;
        bf16x8 qa[4], qb[4];
        { const size_t rowa = (size_t)(b * SEQ + ((128 * n + 64 * qh + r) << sh) + res), rowb = (size_t)(b * SEQ + ((128 * n + 64 * qh + 32 + r) << sh) + res);
#pragma unroll
            for (int ks = 0; ks < 4; ++ks) { qa[ks] = *(const bf16x8*)(PROJ + rowa * NPROJ + head * 64 + 16 * ks + 8 * hh); qb[ks] = *(const bf16x8*)(PROJ + rowb * NPROJ + head * 64 + 16 * ks + 8 * hh); } }
        __syncthreads();
#pragma unroll
        for (int i = 0; i < 4; ++i) { const int key = skey + 64 * i; *(LAS u32x4*)(KS + key * KSTR + sdc * 8) = kreg[i]; *(LAS u32x4*)(VS + key * VSTR + sdc * 8) = vreg[i]; }
        __syncthreads();
        if (ui + 1 < ATT_UNITS / 256) attn_prefetch(PROJ, U + 32, skey, sdc, kreg, vreg);
#pragma unroll 1
        for (int qt = 0; qt < 2; ++qt) {
            const int q0 = 64 * qh + 32 * qt, kt0 = 2 * qh + qt;
            const int lq = 128 * n + q0 + r; const size_t row = (size_t)(b * SEQ + (lq << sh) + res);
            bf16x8 qf[4];
#pragma unroll
            for (int ks = 0; ks < 4; ++ks) qf[ks] = qt ? qb[ks] : qa[ks];
            f32x16 sacc[5];
            const int dq = r - 4 * hh;
#pragma unroll
            for (int k5 = 0; k5 < 5; ++k5) { f32x16 acc;
#pragma unroll
                for (int v = 0; v < 16; ++v) acc[v] = 0.f;
                const bool tile_ok = n > 0 || kt0 + k5 >= 4;
                if (tile_ok) {
#pragma unroll
                    for (int ks = 0; ks < 4; ++ks) { const bf16x8 kf = *(const LAS bf16x8*)(KS + (32 * (kt0 + k5) + r) * KSTR + 16 * ks + 8 * hh); acc = __builtin_amdgcn_mfma_f32_32x32x16_bf16(kf, qf[ks], acc, 0, 0, 0); }
                    if (k5 == 0) {
#pragma unroll
                        for (int v = 0; v < 16; ++v) acc[v] = ((v & 3) + 8 * (v >> 2) >= dq) ? acc[v] : -1e30f; }
                    if (k5 == 4) {
#pragma unroll
                        for (int v = 0; v < 16; ++v) acc[v] = ((v & 3) + 8 * (v >> 2) <= dq) ? acc[v] : -1e30f; }
                } else {
#pragma unroll
                    for (int v = 0; v < 16; ++v) acc[v] = -1e30f; }
                sacc[k5] = acc; }
            float m = -1e30f;
#pragma unroll
            for (int k5 = 0; k5 < 5; ++k5)
#pragma unroll
                for (int v = 0; v < 16; ++v) m = fmaxf(m, sacc[k5][v]);
            m = fmaxf(m, __shfl_xor(m, 32));
            float lsum = 0.f;
#pragma unroll
            for (int k5 = 0; k5 < 5; ++k5) {
                if (n > 0 || kt0 + k5 >= 4) {
#pragma unroll
                    for (int v = 0; v < 16; ++v) { const float pv = __builtin_amdgcn_exp2f(sacc[k5][v] - m); sacc[k5][v] = pv; lsum += pv; } } }
            lsum += __shfl_xor(lsum, 32);
            f32x16 oacc[2];
#pragma unroll
            for (int v = 0; v < 16; ++v) { oacc[0][v] = 0.f; oacc[1][v] = 0.f; }
#pragma unroll
            for (int k5 = 0; k5 < 5; ++k5) { const unsigned vaddr = vs_lane + (unsigned)(32 * (kt0 + k5) * (VSTR * 2));
                if (n > 0 || kt0 + k5 >= 4) { s16x4 t0, t1, t2, t3, t4, t5, t6, t7;
                    asm volatile("ds_read_b64_tr_b16 %0, %8 offset:%9\n\tds_read_b64_tr_b16 %1, %8 offset:%10\n\tds_read_b64_tr_b16 %2, %8 offset:%11\n\tds_read_b64_tr_b16 %3, %8 offset:%12\n\t"
                                 "ds_read_b64_tr_b16 %4, %8 offset:%13\n\tds_read_b64_tr_b16 %5, %8 offset:%14\n\tds_read_b64_tr_b16 %6, %8 offset:%15\n\tds_read_b64_tr_b16 %7, %8 offset:%16\n\ts_waitcnt lgkmcnt(0)"
                                 : "=&v"(t0), "=&v"(t1), "=&v"(t2), "=&v"(t3), "=&v"(t4), "=&v"(t5), "=&v"(t6), "=&v"(t7)
                                 : "v"(vaddr), "i"(0), "i"(8 * VSTR * 2), "i"(64), "i"(8 * VSTR * 2 + 64), "i"(16 * VSTR * 2), "i"(24 * VSTR * 2), "i"(16 * VSTR * 2 + 64), "i"(24 * VSTR * 2 + 64) : "memory");
                    const bf16x8 va0 = {t0[0], t0[1], t0[2], t0[3], t1[0], t1[1], t1[2], t1[3]}, va1 = {t2[0], t2[1], t2[2], t2[3], t3[0], t3[1], t3[2], t3[3]};
                    const bf16x8 vb0 = {t4[0], t4[1], t4[2], t4[3], t5[0], t5[1], t5[2], t5[3]}, vb1 = {t6[0], t6[1], t6[2], t6[3], t7[0], t7[1], t7[2], t7[3]};
                    u32x4 pw;
                    pw.x = pg8::cvt_pk_bf16(sacc[k5][0], sacc[k5][1]); pw.y = pg8::cvt_pk_bf16(sacc[k5][2], sacc[k5][3]); pw.z = pg8::cvt_pk_bf16(sacc[k5][4], sacc[k5][5]); pw.w = pg8::cvt_pk_bf16(sacc[k5][6], sacc[k5][7]);
                    const bf16x8 pf0 = __builtin_bit_cast(bf16x8, pw);
                    pw.x = pg8::cvt_pk_bf16(sacc[k5][8], sacc[k5][9]); pw.y = pg8::cvt_pk_bf16(sacc[k5][10], sacc[k5][11]); pw.z = pg8::cvt_pk_bf16(sacc[k5][12], sacc[k5][13]); pw.w = pg8::cvt_pk_bf16(sacc[k5][14], sacc[k5][15]);
                    const bf16x8 pf1 = __builtin_bit_cast(bf16x8, pw);
                    oacc[0] = __builtin_amdgcn_mfma_f32_32x32x16_bf16(va0, pf0, oacc[0], 0, 0, 0);
                    oacc[1] = __builtin_amdgcn_mfma_f32_32x32x16_bf16(va1, pf0, oacc[1], 0, 0, 0);
                    oacc[0] = __builtin_amdgcn_mfma_f32_32x32x16_bf16(vb0, pf1, oacc[0], 0, 0, 0);
                    oacc[1] = __builtin_amdgcn_mfma_f32_32x32x16_bf16(vb1, pf1, oacc[1], 0, 0, 0); } }
            const float linv = 1.0f / lsum;
            bf16* obase = br == 0 ? OA + row * 512 : (br == 1 ? OB + row * 512 : MIX + row * MIXW);
            obase += head * 64 + 4 * hh;
#pragma unroll
            for (int dt = 0; dt < 2; ++dt)
#pragma unroll
                for (int b4 = 0; b4 < 4; ++b4) { u32x2 w; w.x = pg8::cvt_pk_bf16(oacc[dt][4 * b4 + 0] * linv, oacc[dt][4 * b4 + 1] * linv); w.y = pg8::cvt_pk_bf16(oacc[dt][4 * b4 + 2] * linv, oacc[dt][4 * b4 + 3] * linv);
                    *(u32x2*)(obase + 32 * dt + 8 * b4) = w; }
            if (hh == 0) LSE[((size_t)br * NTOK + row) * 8 + head] = m + __builtin_amdgcn_logf(lsum);
        }
    }
    __syncthreads();
}

#define MFMA16(a_, b_, c_) __builtin_amdgcn_mfma_f32_16x16x32_bf16(a_, b_, c_, 0, 0, 0)
constexpr int BSTR = 144, CSTR = 136, GSTR = 136, XSTR = 136;
#define TR16_READ8(dst, addr, OFF0, OFF1) do { s16x4 _a, _b; asm volatile("ds_read_b64_tr_b16 %0, %2 offset:%3\n\tds_read_b64_tr_b16 %1, %2 offset:%4\n\ts_waitcnt lgkmcnt(0)" : "=&v"(_a), "=&v"(_b) : "v"(addr), "i"(OFF0), "i"(OFF1) : "memory"); \
    dst = (bf16x8){_a[0], _a[1], _a[2], _a[3], _b[0], _b[1], _b[2], _b[3]}; } while (0)
__device__ __forceinline__ float bflo(unsigned w) { return __uint_as_float(w << 16); }
__device__ __forceinline__ float bfhi(unsigned w) { return __uint_as_float(w & 0xffff0000u); }

__device__ __forceinline__ void ssd_s0_load(const bf16* PROJ, const float* DT, int b, int hp, int g, int tc, int pair, u32x4 (&raw)[11], float (&dtv)[8]) {
    const int seg = pair / 48, cc = pair - seg * 48, tb = tc + seg * 8;
    const int col = cc < 16 ? 1792 + hp * 128 + cc * 8 : (cc < 32 ? 2816 + g * 128 + (cc - 16) * 8 : 3072 + g * 128 + (cc - 32) * 8);
#pragma unroll
    for (int i = 0; i < 11; ++i) { const int t = tb - 3 + i; raw[i] = (u32x4){0u, 0u, 0u, 0u}; if (t >= 0) raw[i] = *(const u32x4*)(PROJ + (size_t)(b * SEQ + t) * NPROJ + col); }
#pragma unroll
    for (int i = 0; i < 8; ++i) dtv[i] = cc < 16 ? DT[(size_t)(b * SEQ + tb + i) * 16 + 2 * hp + (cc >> 3)] : 1.0f;
}
__device__ __forceinline__ void ssd_s0_compute(const float* conv_w, const float* conv_b, int hp, int g, int pair, const u32x4 (&raw)[11], const float (&dtv)[8], LAS bf16* BS, LAS bf16* CS_, LAS bf16* XT) {
    const int seg = pair / 48, cc = pair - seg * 48;
    const int xch = cc < 16 ? hp * 128 + cc * 8 : (cc < 32 ? 1024 + g * 128 + (cc - 16) * 8 : 1280 + g * 128 + (cc - 32) * 8);
    u32x4 ot[8];
#pragma unroll
    for (int jp = 0; jp < 4; ++jp) {
        float w0[4], w1[4];
#pragma unroll
        for (int k = 0; k < 4; ++k) { w0[k] = conv_w[k * CONVCH + xch + 2 * jp]; w1[k] = conv_w[k * CONVCH + xch + 2 * jp + 1]; }
        const float b0 = conv_b[xch + 2 * jp], b1 = conv_b[xch + 2 * jp + 1];
#pragma unroll
        for (int i = 0; i < 8; ++i) { float a0 = b0, a1 = b1;
#pragma unroll
            for (int k = 0; k < 4; ++k) { a0 += w0[k] * bflo(raw[i + k][jp]); a1 += w1[k] * bfhi(raw[i + k][jp]); }
            ot[i][jp] = pg8::cvt_pk_bf16(silu(a0) * dtv[i], silu(a1) * dtv[i]); } }
    if (cc < 16) { const int eh = cc >> 3, p0 = (cc & 7) * 8;
#pragma unroll
        for (int jp = 0; jp < 4; ++jp) { u32x4 lo, hi;
#pragma unroll
            for (int k = 0; k < 4; ++k) { lo[k] = (ot[2 * k][jp] & 0xffffu) | (ot[2 * k + 1][jp] << 16); hi[k] = (ot[2 * k][jp] >> 16) | (ot[2 * k + 1][jp] & 0xffff0000u); }
            *(LAS u32x4*)(XT + (eh * 64 + p0 + 2 * jp) * XSTR + seg * 8) = lo; *(LAS u32x4*)(XT + (eh * 64 + p0 + 2 * jp + 1) * XSTR + seg * 8) = hi; } }
    else if (cc < 32) {
#pragma unroll
        for (int i = 0; i < 8; ++i) *(LAS u32x4*)(BS + (seg * 8 + i) * BSTR + (cc - 16) * 8) = ot[i]; }
    else {
#pragma unroll
        for (int i = 0; i < 8; ++i) *(LAS u32x4*)(CS_ + (seg * 8 + i) * CSTR + (cc - 32) * 8) = ot[i]; }
}

__device__ __forceinline__ void cbc_load(const bf16* PROJ, int it, u32x4 (&raw)[11]) {
    const int cc = it & 63, row0 = (it >> 6) * 8, tseq = row0 & (SEQ - 1); const bf16* src = PROJ + (size_t)row0 * NPROJ + 2816 + cc * 8;
#pragma unroll
    for (int i = 0; i < 11; ++i) { raw[i] = (u32x4){0u, 0u, 0u, 0u}; if (tseq - 3 + i >= 0) raw[i] = *(const u32x4*)(src + (ptrdiff_t)(i - 3) * NPROJ); }
}
__device__ __forceinline__ void cbc_compute(const float* conv_w, const float* conv_b, bf16* CBC, int it, const u32x4 (&raw)[11]) {
    const int cc = it & 63, row0 = (it >> 6) * 8, xch = 1024 + cc * 8;
    u32x4 ot[8];
#pragma unroll
    for (int jp = 0; jp < 4; ++jp) {
        float w0[4], w1[4];
#pragma unroll
        for (int k = 0; k < 4; ++k) { w0[k] = conv_w[k * CONVCH + xch + 2 * jp]; w1[k] = conv_w[k * CONVCH + xch + 2 * jp + 1]; }
        const float b0 = conv_b[xch + 2 * jp], b1 = conv_b[xch + 2 * jp + 1];
#pragma unroll
        for (int i = 0; i < 8; ++i) { float a0 = b0, a1 = b1;
#pragma unroll
            for (int k = 0; k < 4; ++k) { a0 += w0[k] * bflo(raw[i + k][jp]); a1 += w1[k] * bfhi(raw[i + k][jp]); }
            ot[i][jp] = pg8::cvt_pk_bf16(silu(a0), silu(a1)); } }
#pragma unroll
    for (int i = 0; i < 8; ++i) *(u32x4*)(CBC + (size_t)(row0 + i) * 512 + cc * 8) = ot[i];
}
__device__ __forceinline__ void cbc_prepass(ArgsP a, int layer, int tid) {
    unsigned char* ws = a->ws; const bf16* PROJ = (const bf16*)(ws + WS_PROJ); bf16* CBC = (bf16*)(ws + WS_CBC);
    const float* conv_w = a->in[4] + (size_t)layer * 4 * CONVCH; const float* conv_b = a->in[5] + (size_t)layer * CONVCH;
    const int nth = gridDim.x * 512;
    const int itb = (blockIdx.x & 7) * 65536 + (blockIdx.x >> 3) * 512 + tid, gstep = nth / 8;
#pragma unroll 1
    for (int k = 0; k < 4; k += 2) { const int it = itb + k * gstep;
        u32x4 rawA[11], rawB[11]; cbc_load(PROJ, it, rawA); cbc_load(PROJ, it + gstep, rawB);
        cbc_compute(conv_w, conv_b, CBC, it, rawA); cbc_compute(conv_w, conv_b, CBC, it + gstep, rawB); }
}

__device__ __forceinline__ void ssd_mfma(ArgsP a, int layer, LAS unsigned char* lds, int tid, int wave, int lane) {
    unsigned char* ws = a->ws;
    const bf16* PROJ = (const bf16*)(ws + WS_PROJ); bf16* MIX = (bf16*)(ws + WS_MIX); const float* DT = (const float*)(ws + WS_DT); float* SSQ4 = (float*)(ws + WS_SSQ);
    const bf16* CBC = (const bf16*)(ws + WS_CBC);
    const float* conv_w = a->in[4] + (size_t)layer * 4 * CONVCH; const float* conv_b = a->in[5] + (size_t)layer * CONVCH;
    LAS bf16* BS = (LAS bf16*)lds; LAS bf16* CS_ = BS + 128 * BSTR; LAS bf16* MS = CS_ + 128 * CSTR; LAS bf16* XT = MS + 2 * 9216;
    LAS float* CSUM = (LAS float*)(XT + 2 * 64 * XSTR); LAS float* DTS = CSUM + 256;
    const int e = wave >> 2, pq = wave & 3, c16 = lane & 15, q = lane >> 4;
    const unsigned bs_tr = (unsigned)(size_t)BS + (unsigned)((8 * q + ((lane & 15) >> 2)) * (BSTR * 2) + 4 * (lane & 3) * 2);
    for (int item = blockIdx.x; item < 256; item += gridDim.x) {
        const int b = (item & 7) * 4 + (item >> 6), hp = (item >> 3) & 7, g = hp >> 2, hh = 2 * hp + e;
        const float A = -__expf(a->in[7][layer * 16 + hh]), Dk0 = a->in[8][layer * 16 + 2 * hp], Dk1 = a->in[8][layer * 16 + 2 * hp + 1];
        f32x4 st[8];
#pragma unroll
        for (int i = 0; i < 8; ++i) st[i] = (f32x4){0.f, 0.f, 0.f, 0.f};
        const int xpair = (tid >> 4) * 48 + (tid & 15);
        u32x4 rawN[11]; float dtN[8];
        if (tid < 256) ssd_s0_load(PROJ, DT, b, hp, g, 0, xpair, rawN, dtN);
#pragma unroll 1
        for (int c = 0; c < 16; ++c) {
            const int tc = c * 128;
            if (pq == 0) { const int l0 = 2 * lane; const float d0 = DT[(size_t)(b * SEQ + tc + l0) * 16 + hh], d1 = DT[(size_t)(b * SEQ + tc + l0 + 1) * 16 + hh];
                const float a0 = d0 * A, a1 = d1 * A; float s = a0 + a1;
#pragma unroll
                for (int o = 1; o < 64; o <<= 1) { const float t = __shfl_up(s, o); if (lane >= o) s += t; }
                CSUM[e * 128 + l0] = s - a1; CSUM[e * 128 + l0 + 1] = s; DTS[e * 128 + l0] = d0; DTS[e * 128 + l0 + 1] = d1; }
            if (tid < 256) ssd_s0_compute(conv_w, conv_b, hp, g, xpair, rawN, dtN, BS, CS_, XT);
            else {
                const int j = tid - 256; const bf16* cb = CBC + (size_t)(b * SEQ + tc) * 512 + g * 128;
#pragma unroll 1
                for (int hb2 = 0; hb2 < 4; ++hb2) { u32x4 cv[4];
#pragma unroll
                    for (int i = 0; i < 4; ++i) { const int id = j + 256 * (4 * hb2 + i), row = id >> 5, cj = id & 31; cv[i] = *(const u32x4*)(cb + (size_t)row * 512 + (cj < 16 ? cj * 8 : 256 + (cj - 16) * 8)); }
#pragma unroll
                    for (int i = 0; i < 4; ++i) { const int id = j + 256 * (4 * hb2 + i), row = id >> 5, cj = id & 31;
                        if (cj < 16) *(LAS u32x4*)(BS + row * BSTR + cj * 8) = cv[i]; else *(LAS u32x4*)(CS_ + row * CSTR + (cj - 16) * 8) = cv[i]; } } }
            __syncthreads();
#pragma unroll 1
            for (int idx = wave; idx < 36; idx += 8) { int lt = 0; while ((lt + 1) * (lt + 2) / 2 <= idx) ++lt; const int stl = idx - lt * (lt + 1) / 2;
                f32x4 acc = {0.f, 0.f, 0.f, 0.f};
#pragma unroll
                for (int ks = 0; ks < 4; ++ks) { const bf16x8 af = *(const LAS bf16x8*)(BS + (16 * stl + c16) * BSTR + 32 * ks + 8 * q), bfr = *(const LAS bf16x8*)(CS_ + (16 * lt + c16) * CSTR + 32 * ks + 8 * q); acc = MFMA16(af, bfr, acc); }
                const int l = 16 * lt + c16, s0 = 16 * stl + 4 * q;
#pragma unroll
                for (int eh = 0; eh < 2; ++eh) { const float csl = CSUM[eh * 128 + l]; const f32x4 cs4 = *(const LAS f32x4*)(CSUM + eh * 128 + s0); const float dsk = (eh ? Dk1 : Dk0) / DTS[eh * 128 + l];
                    float mv[4];
#pragma unroll
                    for (int ee = 0; ee < 4; ++ee) { const int sidx = s0 + ee; const float v = acc[ee] * __expf(csl - cs4[ee]); mv[ee] = sidx < l ? v : (sidx == l ? acc[ee] + dsk : 0.f); }
                    u32x2 w; w.x = pk2(mv[0], mv[1]); w.y = pk2(mv[2], mv[3]);
                    *(LAS u32x2*)(MS + eh * 9216 + idx * 256 + c16 * 16 + 4 * q) = w; } }
            __syncthreads();
            u32x2 zr[8];
#pragma unroll
            for (int lt = 0; lt < 8; ++lt) zr[lt] = *(const u32x2*)(PROJ + (size_t)(b * SEQ + tc + 16 * lt + c16) * NPROJ + 768 + hh * 64 + 16 * pq + 4 * q);
            bf16x8 hb[4];
#pragma unroll
            for (int ks = 0; ks < 4; ++ks) { u32x4 w; w.x = pg8::cvt_pk_bf16(st[2 * ks][0], st[2 * ks][1]); w.y = pg8::cvt_pk_bf16(st[2 * ks][2], st[2 * ks][3]); w.z = pg8::cvt_pk_bf16(st[2 * ks + 1][0], st[2 * ks + 1][1]); w.w = pg8::cvt_pk_bf16(st[2 * ks + 1][2], st[2 * ks + 1][3]); hb[ks] = __builtin_bit_cast(bf16x8, w); }
            const LAS float* csh = CSUM + e * 128;
            const LAS bf16* ms_lane = MS + e * 9216 + (q >> 1) * 256 + c16 * 16 + (q & 1) * 8;
            const float cs_end = csh[127];
#pragma unroll
            for (int lt = 0; lt < 8; ++lt) { const int l = 16 * lt + c16; const float csl = csh[l];
                f32x4 acc = {0.f, 0.f, 0.f, 0.f};
#pragma unroll
                for (int ks = 0; ks < 4; ++ks) { const u32x2 c0 = *(const LAS u32x2*)(CS_ + l * CSTR + 32 * ks + 4 * q), c1 = *(const LAS u32x2*)(CS_ + l * CSTR + 32 * ks + 16 + 4 * q);
                    const u32x4 cw = {c0.x, c0.y, c1.x, c1.y}; acc = MFMA16(hb[ks], __builtin_bit_cast(bf16x8, cw), acc); }
                const float el = __expf(csl); acc = acc * el;
#pragma unroll
                for (int ks = 0; ks < 4; ++ks) if (ks <= (lt >> 1)) { const int s0 = 32 * ks + 8 * q;
                    u32x4 mw = *(const LAS u32x4*)(ms_lane + (lt * (lt + 1) / 2 + 2 * ks) * 256);
                    if ((lt & 1) == 0 && ks == (lt >> 1)) { if (q >= 2) mw = (u32x4){0u, 0u, 0u, 0u}; }
                    const bf16x8 xa = *(const LAS bf16x8*)(XT + (e * 64 + 16 * pq + c16) * XSTR + s0);
                    acc = MFMA16(xa, __builtin_bit_cast(bf16x8, mw), acc); }
                const size_t row = (size_t)(b * SEQ + tc + l);
                const float y0 = acc[0] * silu(bflo(zr[lt].x)), y1 = acc[1] * silu(bfhi(zr[lt].x)), y2 = acc[2] * silu(bflo(zr[lt].y)), y3 = acc[3] * silu(bfhi(zr[lt].y));
                u32x2 ow; ow.x = pg8::cvt_pk_bf16(y0, y1); ow.y = pg8::cvt_pk_bf16(y2, y3);
                *(u32x2*)(MIX + row * MIXW + 512 + hh * 64 + 16 * pq + 4 * q) = ow;
                float ss = (y0 * y0 + y1 * y1) + (y2 * y2 + y3 * y3); ss += __shfl_xor(ss, 16); ss += __shfl_xor(ss, 32);
                if (q == 0) SSQ4[(row * 16 + hh) * 4 + pq] = ss; }
            if (tid < 256) ssd_s0_load(PROJ, DT, b, hp, g, c + 1 < 16 ? tc + 128 : tc, xpair, rawN, dtN);
            { const float dall = __expf(cs_end);
#pragma unroll
                for (int nt = 0; nt < 8; ++nt) st[nt] = st[nt] * dall;
#pragma unroll
                for (int ks = 0; ks < 4; ++ks) { const int l0 = 32 * ks + 8 * q;
                    const u32x4 xw = *(const LAS u32x4*)(XT + (e * 64 + 16 * pq + c16) * XSTR + l0); const f32x4 ca = *(const LAS f32x4*)(csh + l0), cb = *(const LAS f32x4*)(csh + l0 + 4);
                    u32x4 dw;
                    dw.x = pg8::cvt_pk_bf16(bflo(xw.x) * __expf(cs_end - ca.x), bfhi(xw.x) * __expf(cs_end - ca.y)); dw.y = pg8::cvt_pk_bf16(bflo(xw.y) * __expf(cs_end - ca.z), bfhi(xw.y) * __expf(cs_end - ca.w));
                    dw.z = pg8::cvt_pk_bf16(bflo(xw.z) * __expf(cs_end - cb.x), bfhi(xw.z) * __expf(cs_end - cb.y)); dw.w = pg8::cvt_pk_bf16(bflo(xw.w) * __expf(cs_end - cb.z), bfhi(xw.w) * __expf(cs_end - cb.w));
                    const bf16x8 xd = __builtin_bit_cast(bf16x8, dw);
                    const unsigned ba = bs_tr + (unsigned)(32 * ks * (BSTR * 2));
#define SSD_RD4(n0) { s16x4 t0, t1, t2, t3, t4, t5, t6, t7; \
                        asm volatile("ds_read_b64_tr_b16 %0, %8 offset:%9\n\tds_read_b64_tr_b16 %1, %8 offset:%10\n\tds_read_b64_tr_b16 %2, %8 offset:%11\n\tds_read_b64_tr_b16 %3, %8 offset:%12\n\t" \
                                     "ds_read_b64_tr_b16 %4, %8 offset:%13\n\tds_read_b64_tr_b16 %5, %8 offset:%14\n\tds_read_b64_tr_b16 %6, %8 offset:%15\n\tds_read_b64_tr_b16 %7, %8 offset:%16\n\ts_waitcnt lgkmcnt(0)" \
                                     : "=&v"(t0), "=&v"(t1), "=&v"(t2), "=&v"(t3), "=&v"(t4), "=&v"(t5), "=&v"(t6), "=&v"(t7) \
                                     : "v"(ba), "i"((n0) * 32), "i"(4 * BSTR * 2 + (n0) * 32), "i"((n0) * 32 + 32), "i"(4 * BSTR * 2 + (n0) * 32 + 32), "i"((n0) * 32 + 64), "i"(4 * BSTR * 2 + (n0) * 32 + 64), "i"((n0) * 32 + 96), "i"(4 * BSTR * 2 + (n0) * 32 + 96) : "memory"); \
                        st[(n0) + 0] = MFMA16(((bf16x8){t0[0], t0[1], t0[2], t0[3], t1[0], t1[1], t1[2], t1[3]}), xd, st[(n0) + 0]); \
                        st[(n0) + 1] = MFMA16(((bf16x8){t2[0], t2[1], t2[2], t2[3], t3[0], t3[1], t3[2], t3[3]}), xd, st[(n0) + 1]); \
                        st[(n0) + 2] = MFMA16(((bf16x8){t4[0], t4[1], t4[2], t4[3], t5[0], t5[1], t5[2], t5[3]}), xd, st[(n0) + 2]); \
                        st[(n0) + 3] = MFMA16(((bf16x8){t6[0], t6[1], t6[2], t6[3], t7[0], t7[1], t7[2], t7[3]}), xd, st[(n0) + 3]); }
                    SSD_RD4(0) SSD_RD4(4)
#undef SSD_RD4
                } }
            __syncthreads();
        }
    }
}

struct FixRow { u32x4 y0, y1, x0, x1, x2; float ssq, l0, l1, l2; };
__device__ __forceinline__ void fix_load(FixRow& R, const bf16* MIX, const float* SSQ, const bf16* OA, const bf16* OB, const float* LSE, int row, int lane) {
    const int g = lane >> 5, head = lane >> 3; float ssq = 0.f;
#pragma unroll
    for (int i = 0; i < 8; ++i) { const f32x4 qv = *(const f32x4*)(SSQ + (size_t)row * 64 + 32 * g + 4 * i); ssq += (qv.x + qv.y) + (qv.z + qv.w); }
    R.ssq = ssq;
    const u32x4* mp = (const u32x4*)(MIX + (size_t)row * MIXW + 512 + lane * 16); R.y0 = mp[0]; R.y1 = mp[1];
    R.l0 = LSE[(size_t)row * 8 + head]; R.l1 = LSE[((size_t)NTOK + row) * 8 + head]; R.l2 = LSE[((size_t)2 * NTOK + row) * 8 + head];
    R.x0 = *(const u32x4*)(OA + (size_t)row * 512 + lane * 8); R.x1 = *(const u32x4*)(OB + (size_t)row * 512 + lane * 8); R.x2 = *(const u32x4*)(MIX + (size_t)row * MIXW + lane * 8);
}
__device__ __forceinline__ void fix_store(const FixRow& R, bf16* MIX, const f32x4 (&wv)[4], int row, int lane) {
    const float rstd = 1.0f / sqrtf(R.ssq * (1.f / 512.f) + 1e-5f);
    u32x4* mp = (u32x4*)(MIX + (size_t)row * MIXW + 512 + lane * 16);
#pragma unroll
    for (int hlf = 0; hlf < 2; ++hlf) { const u32x4 v = hlf ? R.y1 : R.y0; const f32x4 wa = wv[2 * hlf], wb = wv[2 * hlf + 1]; u32x4 o;
        o.x = pk2(__uint_as_float(v.x << 16) * rstd * wa.x, __uint_as_float(v.x & 0xffff0000u) * rstd * wa.y);
        o.y = pk2(__uint_as_float(v.y << 16) * rstd * wa.z, __uint_as_float(v.y & 0xffff0000u) * rstd * wa.w);
        o.z = pk2(__uint_as_float(v.z << 16) * rstd * wb.x, __uint_as_float(v.z & 0xffff0000u) * rstd * wb.y);
        o.w = pk2(__uint_as_float(v.w << 16) * rstd * wb.z, __uint_as_float(v.w & 0xffff0000u) * rstd * wb.w);
        mp[hlf] = o; }
    const float mx = fmaxf(R.l0, fmaxf(R.l1, R.l2)); float w0 = __builtin_amdgcn_exp2f(R.l0 - mx), w1 = __builtin_amdgcn_exp2f(R.l1 - mx), w2 = __builtin_amdgcn_exp2f(R.l2 - mx); const float wi = 1.0f / (w0 + w1 + w2); w0 *= wi; w1 *= wi; w2 *= wi;
    const u32x4 x0 = R.x0, x1 = R.x1, x2 = R.x2; u32x4 o;
#define MRG(c) pk2(w0 * __uint_as_float(x0.c << 16) + w1 * __uint_as_float(x1.c << 16) + w2 * __uint_as_float(x2.c << 16), w0 * __uint_as_float(x0.c & 0xffff0000u) + w1 * __uint_as_float(x1.c & 0xffff0000u) + w2 * __uint_as_float(x2.c & 0xffff0000u))
    o.x = MRG(x); o.y = MRG(y); o.z = MRG(z); o.w = MRG(w);
#undef MRG
    *(u32x4*)(MIX + (size_t)row * MIXW + lane * 8) = o;
}
__device__ __forceinline__ void phase_fixup(ArgsP a, int layer, int wave, int lane) {
    unsigned char* ws = a->ws; bf16* MIX = (bf16*)(ws + WS_MIX); const float* SSQ = (const float*)(ws + WS_SSQ); const float* w = a->in[9] + (size_t)layer * 1024;
    const bf16* OA = (const bf16*)a->out; const bf16* OB = OA + (size_t)NTOK * 512; const float* LSE = (const float*)(ws + WS_LSE);
    const int gw = blockIdx.x * 8 + wave, NGW = gridDim.x * 8;
    f32x4 wv[4];
#pragma unroll
    for (int i = 0; i < 4; ++i) wv[i] = *(const f32x4*)(w + lane * 16 + 4 * i);
    for (int row = gw; row < NTOK; row += 4 * NGW) {
        FixRow A, B, C, D; fix_load(A, MIX, SSQ, OA, OB, LSE, row, lane); fix_load(B, MIX, SSQ, OA, OB, LSE, row + NGW, lane); fix_load(C, MIX, SSQ, OA, OB, LSE, row + 2 * NGW, lane); fix_load(D, MIX, SSQ, OA, OB, LSE, row + 3 * NGW, lane);
        fix_store(A, MIX, wv, row, lane); fix_store(B, MIX, wv, row + NGW, lane); fix_store(C, MIX, wv, row + 2 * NGW, lane); fix_store(D, MIX, wv, row + 3 * NGW, lane); }
}

__device__ __forceinline__ void dt_side(ArgsP a, int layer, const float* SS, int wave, int lane) {
    unsigned char* ws = a->ws; const bf16* XN = (const bf16*)(ws + WS_XN); const bf16* Wdt = (const bf16*)(ws + WS_WIN) + ((size_t)layer * NPROJ_PAD + NPROJ) * DM; float* DT = (float*)(ws + WS_DT);
    const int c16 = lane & 15, q = lane >> 4, rowbase = blockIdx.x * 256 + wave * 32;
    const float bias = a->in[6][layer * 16 + c16];
    float rsv[2][4];
#pragma unroll
    for (int lt = 0; lt < 2; ++lt)
#pragma unroll
        for (int e = 0; e < 4; ++e) rsv[lt][e] = SS[rowbase + 16 * lt + 4 * q + e];
    f32x4 acc0 = {0.f, 0.f, 0.f, 0.f}, acc1 = acc0;
    const bf16* a0p = XN + (size_t)(rowbase + c16) * DM + 8 * q; const bf16* a1p = a0p + (size_t)16 * DM; const bf16* bp = Wdt + (size_t)c16 * DM + 8 * q;
#pragma unroll 8
    for (int ks = 0; ks < 32; ++ks) { const bf16x8 fa0 = *(const bf16x8*)(a0p + 32 * ks), fa1 = *(const bf16x8*)(a1p + 32 * ks), fb = *(const bf16x8*)(bp + 32 * ks);
        acc0 = MFMA16(fa0, fb, acc0); acc1 = MFMA16(fa1, fb, acc1); }
#pragma unroll
    for (int lt = 0; lt < 2; ++lt)
#pragma unroll
        for (int e = 0; e < 4; ++e) { const int row = rowbase + 16 * lt + 4 * q + e; const float rs = 1.0f / sqrtf(rsv[lt][e] * (1.f / 1024.f) + 1e-5f);
            float v = (lt ? acc1[e] : acc0[e]) * rs + bias; v = v > 20.f ? v : fmaxf(log1pf(__expf(v)), 1e-30f);
            DT[(size_t)row * 16 + c16] = v; }
}

#define XB_TMO      128
#define XB_XCNT(j)  (256  + 64 * (j))
#define XB_XSUB(j)  (1280 + 64 * (j))
#define XB_XGEN(j)  (2304 + 64 * (j))
#define XB_TOP      3328
#define XB_TOPGEN   3392
#define XCD_BAR_WORDS 3456
#define XB_SPIN_CAP (1u << 18)

__device__ __forceinline__ unsigned xb_ld(unsigned* p)              { return __hip_atomic_load(p, __ATOMIC_RELAXED, __HIP_MEMORY_SCOPE_AGENT); }
__device__ __forceinline__ unsigned xb_add(unsigned* p, unsigned v) { return __hip_atomic_fetch_add(p, v, __ATOMIC_RELAXED, __HIP_MEMORY_SCOPE_AGENT); }
__device__ __forceinline__ unsigned xb_xcc_id() { return (unsigned)__builtin_amdgcn_s_getreg((3 << 11) | 20) & 0xFu; }
#define XB_SPIN(cond, bar) do { unsigned _sp = 0; while (cond) { __builtin_amdgcn_s_sleep(1); \
    if ((++_sp & 255u) == 0u) { if (xb_ld(&(bar)[XB_TMO])) break; if (_sp > XB_SPIN_CAP) { atomicAdd(&(bar)[XB_TMO], 1u); break; } } } } while (0)

struct XcdBarrier {
    unsigned* bar; unsigned x;
    volatile LAS unsigned* st;
};

__device__ __forceinline__ XcdBarrier xcd_barrier_post(unsigned* bar, volatile LAS unsigned* st) {
    XcdBarrier b; b.bar = bar; b.x = xb_xcc_id(); b.st = st;
    if (threadIdx.x == 0) (void)xb_add(&bar[XB_XCNT(b.x)], 1u);
    return b;
}
__device__ __forceinline__ void xcd_barrier_complete(unsigned* bar, unsigned x, unsigned& nloc, unsigned& nx) {
    const unsigned G = gridDim.x * gridDim.y * gridDim.z;
    unsigned sum, cnt, mine, sp = 0u;
    for (;;) {
        sum = 0u; cnt = 0u; mine = 0u;
#pragma unroll
        for (unsigned j = 0; j < 16; ++j) { const unsigned c = xb_ld(&bar[XB_XCNT(j)]); sum += c; cnt += (c > 0u) ? 1u : 0u; mine = (j == x) ? c : mine; }
        if (sum == G) break;
        __builtin_amdgcn_s_sleep(1);
        if ((++sp & 255u) == 0u) { if (xb_ld(&bar[XB_TMO])) break; if (sp > XB_SPIN_CAP) { atomicAdd(&bar[XB_TMO], 1u); break; } }
    }
    nloc = mine > 0u ? mine : 1u; nx = cnt > 0u ? cnt : 1u;
}

__device__ __forceinline__ void xcd_barrier(const XcdBarrier& b) {
    asm volatile("s_waitcnt vmcnt(0)" ::: "memory");
    __syncthreads();
    if (threadIdx.x == 0) {
        unsigned* bar = b.bar;
        __builtin_amdgcn_s_waitcnt(0);
        unsigned nloc = b.st[0], nx = b.st[1];
        if (nloc == 0u) { xcd_barrier_complete(bar, b.x, nloc, nx); b.st[0] = nloc; b.st[1] = nx; }
        const unsigned old = xb_add(&bar[XB_XSUB(b.x)], 1u);
        const unsigned gen = old / nloc;
        if (old + 1u == (gen + 1u) * nloc) {
            __builtin_amdgcn_fence(__ATOMIC_RELEASE, "agent");
            asm volatile("s_waitcnt vmcnt(0)" ::: "memory");
            const unsigned og = xb_add(&bar[XB_TOP], 1u);
            const unsigned tg = og / nx;
            if (og + 1u == (tg + 1u) * nx) xb_add(&bar[XB_TOPGEN], 1u);
            else XB_SPIN(xb_ld(&bar[XB_TOPGEN]) == tg, bar);
            __builtin_amdgcn_fence(__ATOMIC_ACQUIRE, "agent");
            xb_add(&bar[XB_XGEN(b.x)], 1u);
            asm volatile("s_waitcnt vmcnt(0)" ::: "memory");
        } else {
            XB_SPIN(xb_ld(&bar[XB_XGEN(b.x)]) == gen, bar);
            __builtin_amdgcn_fence(__ATOMIC_ACQUIRE, "agent");
            asm volatile("s_waitcnt vmcnt(0)" ::: "memory");
        }
    }
    __syncthreads();
}

__global__ void __launch_bounds__(512, 2) fwd_kernel(Args a_by_value) {
    extern __shared__ __attribute__((aligned(16))) unsigned char lds_raw[];
    LAS unsigned char* lds = (LAS unsigned char*)lds_raw;
    ArgsP a0 = (ArgsP)__builtin_amdgcn_kernarg_segment_ptr();
    cg::grid_group grid = cg::this_grid();
    const int G = gridDim.x;
    volatile LAS unsigned* bar_st = (volatile LAS unsigned*)(lds + LDS_BYTES - 16);
    if (threadIdx.x < 2) bar_st[threadIdx.x] = 0u;
    __syncthreads();
    XcdBarrier bar = xcd_barrier_post((unsigned*)a0->ws, bar_st);
    const int ph_lo = a0->ph_lo, ph_hi = a0->ph_hi;
    for (int ph = ph_lo; ph < ph_hi; ++ph) {
        ArgsP a = a0; asm volatile("" : "+s"(a));
        unsigned char* ws = a->ws;
        int tid = threadIdx.x; asm volatile("" : "+v"(tid));
        const int lane = tid & 63, wave = __builtin_amdgcn_readfirstlane(tid >> 6);
        float* SSP = (float*)(ws + WS_SSP);
        if (ph == 0) { if (PHM & 1) phase_prologue(a, lds, wave, lane); }
        else if (ph == NPHASE - 1) {
            const int gw = blockIdx.x * 8 + wave, NGW = G * 8; const float* sp = SSP + (size_t)4 * NTOK; const float* w = a->in[15]; float* out = a->out;
            const bf16* hbf = (const bf16*)(ws + WS_XN);
            f32x4 wq[4];
#pragma unroll
            for (int j = 0; j < 2; ++j) { wq[2 * j] = ((const f32x4*)w)[2 * lane + 128 * j]; wq[2 * j + 1] = ((const f32x4*)w)[2 * lane + 128 * j + 1]; }
            for (int k = 0; k < 32; k += 2) { const int m = (blockIdx.x & 7) * 8192 + (blockIdx.x >> 3) * 8 + wave + 256 * k;
                const float s0 = sp[m], s1 = sp[m + 256]; u32x4 hv[2][2];
#pragma unroll
                for (int h2 = 0; h2 < 2; ++h2)
#pragma unroll
                    for (int j = 0; j < 2; ++j) hv[h2][j] = ((const u32x4*)(hbf + (size_t)(m + h2 * 256) * DM))[lane + 64 * j];
#pragma unroll
                for (int h2 = 0; h2 < 2; ++h2) { const float rstd = 1.0f / sqrtf((h2 ? s1 : s0) * (1.f / 1024.f) + 1e-5f); f32x4* xr = (f32x4*)(out + (size_t)(m + h2 * 256) * DM) + 2 * lane;
#pragma unroll
                    for (int j = 0; j < 2; ++j) { const u32x4 h = hv[h2][j]; const f32x4 wa = wq[2 * j], wb = wq[2 * j + 1];
                        xr[128 * j] = (f32x4){__uint_as_float(h.x << 16) * rstd * wa.x, __uint_as_float(h.x & 0xffff0000u) * rstd * wa.y, __uint_as_float(h.y << 16) * rstd * wa.z, __uint_as_float(h.y & 0xffff0000u) * rstd * wa.w};
                        xr[128 * j + 1] = (f32x4){__uint_as_float(h.z << 16) * rstd * wb.x, __uint_as_float(h.z & 0xffff0000u) * rstd * wb.y, __uint_as_float(h.w << 16) * rstd * wb.z, __uint_as_float(h.w & 0xffff0000u) * rstd * wb.w}; } } }
        } else {
            const int l = (ph - 1) / 6, s = (ph - 1) - 6 * l;
            if (s == 0 && (PHM & 2)) {
                pg8::Gemm g{(const pg8::bf16_t*)(ws + WS_XN), (const pg8::bf16_t*)(ws + WS_WIN) + (size_t)l * NPROJ_PAD * DM, NTOK, NPROJ, DM};
                pg8::StaticOrder S; S.init(NTOK, NPROJ, G, (int)blockIdx.x);
                pg8::EpiInProj E{(pg8::bf16_t*)(ws + WS_PROJ), (float*)(ws + WS_DT), (const float*)(ws + WS_CS), a->in[6] + l * 16, SSP + (size_t)(2 * l) * NTOK};
                pg8::gemm_phase<pg8::EpiInProj, pg8::StaticOrder>(lds, g, S, E, nullptr);
                dt_side(a, l, SSP + (size_t)(2 * l) * NTOK, wave, lane);
            } else if (s == 1) {
                if (PHM & 4) { cbc_prepass(a, l, tid); xcd_barrier(bar); ssd_mfma(a, l, lds, tid, wave, lane); }
                if (PHM & 8) attn_mfma(a, lds, tid, wave, lane);
            } else if (s == 2 && (PHM & 16)) {
                phase_fixup(a, l, wave, lane);
            } else if (s == 3 && (PHM & 32)) {
                pg8::Gemm g{(const pg8::bf16_t*)(ws + WS_MIX), (const pg8::bf16_t*)(ws + WS_WOUT) + (size_t)l * DM * MIXW, NTOK, DM, MIXW};
                pg8::StaticOrder S; S.init(NTOK, DM, G, (int)blockIdx.x);
                pg8::EpiRes E{(pg8::bf16_t*)(ws + WS_XN), SSP + (size_t)(2 * l + 1) * NTOK};
                pg8::gemm_phase<pg8::EpiRes, pg8::StaticOrder>(lds, g, S, E, nullptr);
            } else if (s == 4 && (PHM & 128)) {
                pg8::Gemm g{(const pg8::bf16_t*)(ws + WS_XN), (const pg8::bf16_t*)(ws + WS_WGU) + (size_t)l * 2 * FFN * DM, NTOK, 2 * FFN, DM};
                pg8::StaticOrder S; S.init(NTOK, 2 * FFN, G, (int)blockIdx.x);
                pg8::EpiGateUp E{(pg8::bf16_t*)(ws + WS_PROJ), SSP + (size_t)(2 * l + 1) * NTOK};
                pg8::gemm_phase<pg8::EpiGateUp, pg8::StaticOrder>(lds, g, S, E, nullptr);
            } else if (s == 5 && (PHM & 256)) {
                pg8::Gemm g{(const pg8::bf16_t*)(ws + WS_PROJ), (const pg8::bf16_t*)(ws + WS_WDN) + (size_t)l * DM * FFN, NTOK, DM, FFN};
                pg8::StaticOrder S; S.init(NTOK, DM, G, (int)blockIdx.x);
                pg8::EpiRes E{(pg8::bf16_t*)(ws + WS_XN), SSP + (size_t)(2 * l + 2) * NTOK};
                pg8::gemm_phase<pg8::EpiRes, pg8::StaticOrder>(lds, g, S, E, nullptr);
            }
        }
        if (ph + 1 < ph_hi) { if (ph_hi > 1000) grid.sync(); else xcd_barrier(bar); }
    }
}

extern "C" void kernel_launch(void* const* d_in, const int* in_sizes, int n_in, void* d_out, int out_size, void* d_ws, size_t ws_size, hipStream_t stream) {
    static int ready = 0;
    if (!ready) {
        if (n_in != 16 || out_size != NTOK * DM || ws_size < WS_END) { fprintf(stderr, "kernel_launch: unexpected shapes (n_in %d, out %d, ws %zu)\n", n_in, out_size, ws_size); ready = -1; return; }
        if (hipFuncSetAttribute((const void*)fwd_kernel, hipFuncAttributeMaxDynamicSharedMemorySize, LDS_BYTES) != hipSuccess) { fprintf(stderr, "kernel_launch: hipFuncSetAttribute failed\n"); ready = -1; return; }
        ready = 1;
    }
    if (ready < 0) return;
    if (hipMemsetAsync(d_ws, 0, 16384, stream) != hipSuccess) { fprintf(stderr, "kernel_launch: memset of the barrier words failed\n"); return; }
    Args a{};
    for (int i = 0; i < 16; ++i) a.in[i] = (const float*)d_in[i];
    a.out = (float*)d_out; a.ws = (unsigned char*)d_ws;
    for (int i = 0; i < 8; ++i) a.inv_freq[i] = (float)pow(500000.0, -(double)(2 * i) / 16.0);
#if ONE_LAUNCH
    a.ph_lo = 0; a.ph_hi = NPHASE;
    void* args[] = {&a};
    hipError_t e = hipLaunchCooperativeKernel((const void*)fwd_kernel, dim3(256), dim3(512), args, LDS_BYTES, stream);
    if (e != hipSuccess) fprintf(stderr, "cooperative launch failed: %s\n", hipGetErrorString(e));
#else
    for (int ph = 0; ph < NPHASE; ++ph) { a.ph_lo = ph; a.ph_hi = ph + 1; hipLaunchKernelGGL(fwd_kernel, dim3(256), dim3(512), LDS_BYTES, stream, a); }
#endif
}
```

```cpp
#include <hip/hip_runtime.h>
#include <hip/hip_cooperative_groups.h>
#include <cstdio>
#include <cmath>
namespace cg = cooperative_groups;
#ifndef PHM
#define PHM 511
#endif
#ifndef ONE_LAUNCH
#define ONE_LAUNCH 1
#endif
namespace pg8 {
#define PG8_LAS __attribute__((address_space(3)))
typedef unsigned short bf16_t;
typedef short bf16x8 __attribute__((ext_vector_type(8)));
typedef float f32x4 __attribute__((ext_vector_type(4)));
typedef unsigned u32x4 __attribute__((ext_vector_type(4)));
constexpr int BM = 256, BK = 64, HALF = 128, HTB = HALF * BK * 2  , STAGE_BYTES = 8 * HTB, NXCD = 8, WGM = 4;

__host__ __device__ __forceinline__ int lds_byte(int r, int c) { const int st = (r >> 4) * 2 + (c >> 5), rr = r & 15, cc = c & 31, ob = rr * 64 + cc * 2; return st * 1024 + (ob ^ (((ob >> 9) & 1) << 5)); }
__host__ __device__ __forceinline__ void stage_rc(int b, int& R, int& C) { const int st = b / 1024, sb = b % 1024, swz = sb ^ (((sb >> 9) & 1) << 5); R = (st >> 1) * 16 + swz / 64; C = (st & 1) * 32 + (swz % 64) / 2; }
__host__ __device__ __forceinline__ int perm32(int rho) { const int n = rho >> 4, i = rho & 15; return 8 * (i >> 2) + 4 * n + (i & 3); }

struct Unit { int pm, pn; };
struct Gemm { const bf16_t* A; const bf16_t* Bt; int M, N, K; };

struct StaticOrder {
    int nM, nN, nwg, G, c;
    __host__ __device__ void init(int M, int N, int G_, int c_) { nM = M / BM; nN = N / BM; nwg = nM * nN; G = G_; c = c_; }
    __host__ __device__ bool next(int i, Unit& u) const {
        const long L = (long)i * G + c; if (L >= nwg) return false;
        int wgid = (int)L; { const int q = nwg / NXCD, r = nwg % NXCD, xcd = wgid % NXCD, off = wgid / NXCD; wgid = (xcd < r ? xcd * (q + 1) : r * (q + 1) + (xcd - r) * q) + off; }
        const int nig = WGM * nN, gid = wgid / nig, fm = gid * WGM, gsz = (nM - fm) < WGM ? (nM - fm) : WGM;
        u.pm = fm + ((wgid % nig) % gsz); u.pn = (wgid % nig) / gsz; return true;
    }
    __device__ __forceinline__ void a_ready(const Unit&) const {}
    __device__ __forceinline__ void done(const Unit&) const {}
};
__device__ __forceinline__ unsigned cvt_pk_bf16(float lo, float hi) { unsigned r; asm volatile("v_cvt_pk_bf16_f32 %0, %1, %2" : "=v"(r) : "v"(lo), "v"(hi)); return r; }
typedef float f32x2 __attribute__((ext_vector_type(2)));
template <class Epi, class Sched, bool STAMP = false>
__device__ __forceinline__ void gemm_phase(PG8_LAS unsigned char* lds, const Gemm g, const Sched& S, const Epi& E, unsigned long long* stamps) {
    int tid_ = threadIdx.x; asm volatile("" : "+v"(tid_));
    const int tid = tid_, wid = __builtin_amdgcn_readfirstlane(tid >> 6), lane = tid & 63, wr = wid >> 2, wc = wid & 3, fr = lane & 15, fq = lane >> 4;
    const int K = g.K, nt = K / BK;
    int ts_lo = 0, ts_hi = 0, nts = 0; const unsigned long long rt_entry = STAMP ? (unsigned long long)wall_clock64() : 0ull;
#define PG8_STAMP() do { if (STAMP && wid == 0 && nts < 64) { const unsigned long long _c = (unsigned long long)clock64(); \
        ts_lo = (lane == nts) ? (int)(unsigned)_c : ts_lo; ts_hi = (lane == nts) ? (int)(unsigned)(_c >> 32) : ts_hi; ++nts; } } while (0)
    PG8_STAMP();
    unsigned voffA[2], voffB[2];
#pragma unroll
    for (int i = 0; i < 2; ++i) { int R, C; stage_rc(tid * 16 + i * 8192, R, C); const int Rb = Epi::PERM ? ((R & ~31) + perm32(R & 31)) : R;
        voffA[i] = (unsigned)(R * K + C) * 2u; voffB[i] = (unsigned)(Rb * K + C) * 2u; }
    const size_t kstep = (size_t)(BK * 2);
    const size_t hstep = (size_t)HALF * K * 2;
    const size_t tstep = 2 * hstep;
    const unsigned ldsw = (unsigned)wid * 1024u;
    const int aoff = lds_byte(wr * 64 + fr, fq * 8), boff = lds_byte(wc * 32 + fr, fq * 8);
#define PG8_SA(b, h) (((b) * 2 + (h)) * HTB)
#define PG8_SB(b, h) ((4 + (b) * 2 + (h)) * HTB)
#define PG8_STAGE(bufoff, gbase, voff) do { _Pragma("unroll") for (int _i = 0; _i < 2; ++_i) \
        __builtin_amdgcn_global_load_lds((const unsigned*)((const char*)(gbase) + (voff)[_i]), (PG8_LAS unsigned*)(lds + (bufoff) + ldsw + _i * 8192), 16, 0, 0); } while (0)
#define PG8_LDA(dst, b, h) do { _Pragma("unroll") for (int m = 0; m < 4; ++m) _Pragma("unroll") for (int k = 0; k < 2; ++k) dst[m][k] = *(const PG8_LAS bf16x8*)(lds + PG8_SA(b, h) + aoff + m * 2048 + k * 1024); } while (0)
#define PG8_LDB(dst, b, h) do { _Pragma("unroll") for (int n = 0; n < 2; ++n) _Pragma("unroll") for (int k = 0; k < 2; ++k) dst[n][k] = *(const PG8_LAS bf16x8*)(lds + PG8_SB(b, h) + boff + n * 2048 + k * 1024); } while (0)
#define PG8_MMA(ai, bj, At, Bt) do { __builtin_amdgcn_s_setprio(1); _Pragma("unroll") for (int m = 0; m < 4; ++m) _Pragma("unroll") for (int n = 0; n < 2; ++n) _Pragma("unroll") for (int k = 0; k < 2; ++k) \
        acc[ai][bj][m][n] = __builtin_amdgcn_mfma_f32_16x16x32_bf16(Bt[n][k], At[m][k], acc[ai][bj][m][n], 0, 0, 0); __builtin_amdgcn_s_setprio(0); } while (0)
#define PG8_WAIT_V(n) asm volatile("s_waitcnt vmcnt(" #n ")" ::: "memory")
#define PG8_WAIT_L(n) asm volatile("s_waitcnt lgkmcnt(" #n ")" ::: "memory")
#define PG8_BAR __builtin_amdgcn_s_barrier()
#define PG8_SCHED __builtin_amdgcn_sched_barrier(0)
    Unit cur, nxt; int ui = 0;
    if (!S.next(0, cur)) return;
    f32x4 acc[2][2][4][2];
#pragma unroll
    for (int a = 0; a < 2; ++a)
#pragma unroll
        for (int b = 0; b < 2; ++b)
#pragma unroll
            for (int m = 0; m < 4; ++m)
#pragma unroll
                for (int n = 0; n < 2; ++n) acc[a][b][m][n] = (f32x4){0.f, 0.f, 0.f, 0.f};
    bf16x8 At[4][2], B0[2][2], B1[2][2];
    const char* cA = (const char*)g.A + (size_t)cur.pm * tstep; const char* cB = (const char*)g.Bt + (size_t)cur.pn * tstep;
    S.a_ready(cur);
    PG8_STAGE(PG8_SB(0, 0), cB, voffB); PG8_STAGE(PG8_SA(0, 0), cA, voffA); PG8_STAGE(PG8_SB(0, 1), cB + hstep, voffB); PG8_STAGE(PG8_SA(0, 1), cA + hstep, voffA);
    if (wr == 1) PG8_BAR;
    PG8_WAIT_V(4); PG8_BAR;
    PG8_STAGE(PG8_SB(1, 0), cB + kstep, voffB); PG8_STAGE(PG8_SA(1, 0), cA + kstep, voffA); PG8_STAGE(PG8_SB(1, 1), cB + hstep + kstep, voffB);
    PG8_WAIT_V(6); PG8_BAR;
    PG8_STAMP();
    for (;;) {
        const bool has_next = S.next(ui + 1, nxt);
        const char* nA = has_next ? (const char*)g.A + (size_t)nxt.pm * tstep : cA; const char* nB = has_next ? (const char*)g.Bt + (size_t)nxt.pn * tstep : cB;
        for (int t = 0; t < nt; t += 2) {
            const bool last = (t == nt - 2);
            const char* a1 = cA + (size_t)(t + 1) * kstep;
            const char* a2 = last ? nA : cA + (size_t)(t + 2) * kstep; const char* b2 = last ? nB : cB + (size_t)(t + 2) * kstep;
            const char* a3 = a2 + kstep; const char* b3 = b2 + kstep;
            if (last && has_next) S.a_ready(nxt);
            PG8_LDB(B0, 0, 0); PG8_SCHED; PG8_LDA(At, 0, 0); PG8_STAGE(PG8_SA(1, 1), a1 + hstep, voffA);
            PG8_WAIT_L(8); PG8_BAR; PG8_WAIT_L(0); PG8_MMA(0, 0, At, B0); PG8_BAR; PG8_SCHED;
            PG8_LDB(B1, 0, 1); PG8_STAGE(PG8_SB(0, 0), b2, voffB);
            PG8_BAR; PG8_WAIT_L(0); PG8_MMA(0, 1, At, B1); PG8_BAR;
            PG8_LDA(At, 0, 1); PG8_STAGE(PG8_SA(0, 0), a2, voffA);
            PG8_BAR; PG8_WAIT_L(0); PG8_MMA(1, 0, At, B0); PG8_BAR; PG8_SCHED;
            PG8_STAGE(PG8_SB(0, 1), b2 + hstep, voffB);
            PG8_WAIT_V(6); PG8_BAR; PG8_MMA(1, 1, At, B1); PG8_BAR;
            PG8_LDB(B0, 1, 0); PG8_SCHED; PG8_LDA(At, 1, 0); PG8_STAGE(PG8_SA(0, 1), a2 + hstep, voffA);
            PG8_WAIT_L(8); PG8_BAR; PG8_WAIT_L(0); PG8_MMA(0, 0, At, B0); PG8_BAR; PG8_SCHED;
            PG8_LDB(B1, 1, 1); PG8_STAGE(PG8_SB(1, 0), b3, voffB);
            PG8_BAR; PG8_WAIT_L(0); PG8_MMA(0, 1, At, B1); PG8_BAR;
            PG8_LDA(At, 1, 1); PG8_STAGE(PG8_SA(1, 0), a3, voffA);
            PG8_BAR; PG8_WAIT_L(0); PG8_MMA(1, 0, At, B0); PG8_BAR; PG8_SCHED;
            PG8_STAGE(PG8_SB(1, 1), b3 + hstep, voffB);
            PG8_WAIT_V(6); PG8_BAR; PG8_MMA(1, 1, At, B1); PG8_BAR;
        }
        PG8_STAMP();
        if constexpr (!Epi::AFTER_DRAIN) { E(acc, cur, wr, wc, fr, fq); S.done(cur); }
        PG8_STAMP();
        if (!has_next) break;
#pragma unroll
        for (int a = 0; a < 2; ++a)
#pragma unroll
            for (int b = 0; b < 2; ++b)
#pragma unroll
                for (int m = 0; m < 4; ++m)
#pragma unroll
                    for (int n = 0; n < 2; ++n) acc[a][b][m][n] = (f32x4){0.f, 0.f, 0.f, 0.f};
        cur = nxt; cA = nA; cB = nB; ++ui;
    }
    PG8_WAIT_V(0);
    if (wr == 0) PG8_BAR;
    PG8_BAR;
    if constexpr (Epi::AFTER_DRAIN) { E.fused(acc, cur, wr, wc, fr, fq, lds, wid, lane); S.done(cur); }
    PG8_STAMP();
    if (STAMP && wid == 0) { stamps[lane] = lane < nts ? (((unsigned long long)(unsigned)ts_hi << 32) | (unsigned)ts_lo) : 0ull;
        if (lane == 62) stamps[62] = rt_entry; if (lane == 63) stamps[63] = (unsigned long long)wall_clock64(); }
#undef PG8_STAMP
#undef PG8_SA
#undef PG8_SB
#undef PG8_STAGE
#undef PG8_LDA
#undef PG8_LDB
#undef PG8_MMA
#undef PG8_WAIT_V
#undef PG8_WAIT_L
#undef PG8_BAR
#undef PG8_SCHED
}
}

namespace pg8 {
__device__ __forceinline__ float silu_f(float x) { return x * __builtin_amdgcn_rcpf(1.0f + __expf(-x)); }

struct EpiInProj {
    static constexpr bool PERM = true, AFTER_DRAIN = false;
    bf16_t* P; float* DT; const float* CS; const float* dt_bias; const float* SSP;
    __device__ __forceinline__ float row_rstd(int row) const { return 1.0f / sqrtf(SSP[row] * (1.f / 1024.f) + 1e-5f); }
    __device__ __forceinline__ void operator()(const f32x4 (&acc)[2][2][4][2], const Unit& u, int wr, int wc, int fr, int fq) const {
        const int row0 = u.pm * BM + wr * 64 + fr; const int pn = u.pn;
        float rsv[2][4];
#pragma unroll
        for (int ai = 0; ai < 2; ++ai)
#pragma unroll
            for (int m = 0; m < 4; ++m) rsv[ai][m] = SSP[row0 + ai * HALF + m * 16];
        if (pn == 13) {
            if (wc == 0 && fq < 2) {
                const f32x4 b0 = *(const f32x4*)(dt_bias + 8 * fq), b1 = *(const f32x4*)(dt_bias + 8 * fq + 4);
#pragma unroll
                for (int ai = 0; ai < 2; ++ai)
#pragma unroll
                    for (int m = 0; m < 4; ++m) { const int row = row0 + ai * HALF + m * 16;
                        const float rs = 1.0f / sqrtf(rsv[ai][m] * (1.f / 1024.f) + 1e-5f); f32x4 v0 = acc[ai][0][m][0] * rs + b0, v1 = acc[ai][0][m][1] * rs + b1;
#pragma unroll
                        for (int e = 0; e < 4; ++e) { v0[e] = v0[e] > 20.f ? v0[e] : fmaxf(log1pf(__expf(v0[e])), 1e-30f); v1[e] = v1[e] > 20.f ? v1[e] : fmaxf(log1pf(__expf(v1[e])), 1e-30f); }
                        *(f32x4*)(DT + (size_t)row * 16 + 8 * fq) = v0; *(f32x4*)(DT + (size_t)row * 16 + 8 * fq + 4) = v1; }
            }
            return;
        }
        const bool rot_wave = (pn < 3) && ((wc & 1) == 0);
#pragma unroll
        for (int ai = 0; ai < 2; ++ai)
#pragma unroll
          for (int mb = 0; mb < 4; mb += 2) {
            f32x4 csv[2][4];
#pragma unroll
            for (int mi = 0; mi < 2; ++mi)
#pragma unroll
                for (int i = 0; i < 4; ++i) csv[mi][i] = (i < 2) ? (f32x4){1.f, 1.f, 1.f, 1.f} : (f32x4){0.f, 0.f, 0.f, 0.f};
            if (rot_wave) {
#pragma unroll
                for (int mi = 0; mi < 2; ++mi) { const float* cs = CS + (size_t)(row0 + ai * HALF + (mb + mi) * 16) * 16;
#pragma unroll
                    for (int i = 0; i < 4; ++i) csv[mi][i] = *(const f32x4*)(cs + 4 * i); } }
#pragma unroll
            for (int mi = 0; mi < 2; ++mi) { const int m = mb + mi; const int row = row0 + ai * HALF + m * 16;
                const f32x4 c0 = csv[mi][0], c1 = csv[mi][1], s0 = csv[mi][2], s1 = csv[mi][3];
                bf16_t* rowp = P + (size_t)row * 3328 + pn * 256 + wc * 32 + 8 * fq; const float rs = 1.0f / sqrtf(rsv[ai][m] * (1.f / 1024.f) + 1e-5f);
#pragma unroll
                for (int bj = 0; bj < 2; ++bj) { f32x4 v0 = acc[ai][bj][m][0] * rs, v1 = acc[ai][bj][m][1] * rs;
                    const bool rope = rot_wave && (pn < 2 || bj == 0);
                    if (rope) { f32x4 p0, p1;
#pragma unroll
                        for (int e = 0; e < 4; ++e) { p0[e] = __shfl_xor(v0[e], 16); p1[e] = __shfl_xor(v1[e], 16); }
                        if (fq < 2) { const float sg = fq == 0 ? -1.f : 1.f; v0 = v0 * c0 + sg * (p0 * s0); v1 = v1 * c1 + sg * (p1 * s1); } }
                    if (pn < 2) { v0 = v0 * 0.18033688011112042f; v1 = v1 * 0.18033688011112042f; }
                    u32x4 w; w.x = cvt_pk_bf16(v0[0], v0[1]); w.y = cvt_pk_bf16(v0[2], v0[3]); w.z = cvt_pk_bf16(v1[0], v1[1]); w.w = cvt_pk_bf16(v1[2], v1[3]);
                    *(u32x4*)(rowp + bj * HALF) = w; } } }
    }
};
struct EpiRes {
    static constexpr bool PERM = true, AFTER_DRAIN = false;
    bf16_t* hb; float* ssp;
    __device__ __forceinline__ void operator()(const f32x4 (&acc)[2][2][4][2], const Unit& u, int wr, int wc, int fr, int fq) const {
        const int row0 = u.pm * BM + wr * 64 + fr, col0 = u.pn * BM + wc * 32 + 8 * fq;
        u32x4 bwv[2][4][2];
#pragma unroll
        for (int ai = 0; ai < 2; ++ai)
#pragma unroll
            for (int m = 0; m < 4; ++m) { const bf16_t* hp = hb + (size_t)(row0 + ai * HALF + m * 16) * 1024 + col0; bwv[ai][m][0] = *(const u32x4*)(hp); bwv[ai][m][1] = *(const u32x4*)(hp + HALF); }
#pragma unroll
        for (int ai = 0; ai < 2; ++ai) {
#pragma unroll
            for (int m = 0; m < 4; ++m) { const int row = row0 + ai * HALF + m * 16; bf16_t* hp = hb + (size_t)row * 1024 + col0; float ss = 0.f;
                const u32x4 bw0 = bwv[ai][m][0], bw1 = bwv[ai][m][1];
#pragma unroll
                for (int bj = 0; bj < 2; ++bj) { const u32x4 bw = bj ? bw1 : bw0;
                    f32x4 v0 = acc[ai][bj][m][0], v1 = acc[ai][bj][m][1];
                    v0[0] += __uint_as_float(bw.x << 16); v0[1] += __uint_as_float(bw.x & 0xffff0000u); v0[2] += __uint_as_float(bw.y << 16); v0[3] += __uint_as_float(bw.y & 0xffff0000u);
                    v1[0] += __uint_as_float(bw.z << 16); v1[1] += __uint_as_float(bw.z & 0xffff0000u); v1[2] += __uint_as_float(bw.w << 16); v1[3] += __uint_as_float(bw.w & 0xffff0000u);
                    ss += ((v0[0] * v0[0] + v0[1] * v0[1]) + (v0[2] * v0[2] + v0[3] * v0[3])) + ((v1[0] * v1[0] + v1[1] * v1[1]) + (v1[2] * v1[2] + v1[3] * v1[3]));
                    u32x4 w; w.x = cvt_pk_bf16(v0[0], v0[1]); w.y = cvt_pk_bf16(v0[2], v0[3]); w.z = cvt_pk_bf16(v1[0], v1[1]); w.w = cvt_pk_bf16(v1[2], v1[3]); *(u32x4*)(hp + bj * HALF) = w; }
                ss += __shfl_xor(ss, 16); ss += __shfl_xor(ss, 32);
                if (fq == 0) __hip_atomic_fetch_add(ssp + row, ss, __ATOMIC_RELAXED, __HIP_MEMORY_SCOPE_AGENT); } }
    }
};
struct EpiGateUp {
    static constexpr bool PERM = true, AFTER_DRAIN = false;
    bf16_t* H; const float* SSP;
    __device__ __forceinline__ void operator()(const f32x4 (&acc)[2][2][4][2], const Unit& u, int wr, int wc, int fr, int fq) const {
        const int row0 = u.pm * BM + wr * 64 + fr, col0 = u.pn * HALF + wc * 32 + 8 * fq;
        float rsv[2][4];
#pragma unroll
        for (int ai = 0; ai < 2; ++ai)
#pragma unroll
            for (int m = 0; m < 4; ++m) rsv[ai][m] = SSP[row0 + ai * HALF + m * 16];
#pragma unroll
        for (int ai = 0; ai < 2; ++ai)
#pragma unroll
            for (int m = 0; m < 4; ++m) { const float rs = 1.0f / sqrtf(rsv[ai][m] * (1.f / 1024.f) + 1e-5f);
                const f32x4 g0 = acc[ai][0][m][0] * rs, g1 = acc[ai][0][m][1] * rs, u0 = acc[ai][1][m][0] * rs, u1 = acc[ai][1][m][1] * rs; f32x4 h0, h1;
#pragma unroll
                for (int e = 0; e < 4; ++e) { h0[e] = silu_f(g0[e]) * u0[e]; h1[e] = silu_f(g1[e]) * u1[e]; }
                u32x4 w; w.x = cvt_pk_bf16(h0[0], h0[1]); w.y = cvt_pk_bf16(h0[2], h0[3]); w.z = cvt_pk_bf16(h1[0], h1[1]); w.w = cvt_pk_bf16(h1[2], h1[3]);
                *(u32x4*)(H + (size_t)(row0 + ai * HALF + m * 16) * 2816 + col0) = w; }
    }
};
}

#define LAS __attribute__((address_space(3)))
typedef unsigned short bf16;
typedef float f32x4 __attribute__((ext_vector_type(4)));
typedef unsigned u32x4 __attribute__((ext_vector_type(4)));
typedef unsigned u32x2 __attribute__((ext_vector_type(2)));

constexpr int NTOK = 65536, DM = 1024, SEQ = 2048;
constexpr int NPROJ = 3328, NPROJ_PAD = 3584, NPROJ_SRC = 3344, MIXW = 1536, FFN = 2816, CONVCH = 1536;
constexpr size_t MiB = 1u << 20;
constexpr size_t WS_WIN = 1 * MiB, WS_WOUT = 15 * MiB, WS_WGU = 21 * MiB, WS_WDN = 43 * MiB, WS_CS = 54 * MiB, WS_DT = 58 * MiB, WS_SSQ = 808 * MiB,
                 WS_XN = 66 * MiB, WS_PROJ = 194 * MiB, WS_MIX = 610 * MiB, WS_LSE = 802 * MiB, WS_SSP = 824 * MiB, WS_CBC = 844 * MiB, WS_END = 908 * MiB;
constexpr int LDS_BYTES = 147456;
constexpr int NPHASE = 14;

__device__ __forceinline__ float bf2f(unsigned short b) { return __uint_as_float(((unsigned)b) << 16); }
__device__ __forceinline__ unsigned f2bf(float f) { unsigned u = __float_as_uint(f); return (u + 0x7fffu + ((u >> 16) & 1u)) >> 16; }
__device__ __forceinline__ unsigned pk2(float lo, float hi) { return f2bf(lo) | (f2bf(hi) << 16); }
__device__ __forceinline__ float silu(float x) { return x * __builtin_amdgcn_rcpf(1.0f + __expf(-x)); }
__device__ __forceinline__ float wave_sum(float v) {
#pragma unroll
    for (int o = 1; o < 64; o <<= 1) v += __shfl_xor(v, o);
    return v;
}
__device__ __forceinline__ float wave_max(float v) {
#pragma unroll
    for (int o = 1; o < 64; o <<= 1) v = fmaxf(v, __shfl_xor(v, o));
    return v;
}
#define LDS_WAIT() asm volatile("s_waitcnt lgkmcnt(0)" ::: "memory")

struct Args { const float* in[16]; float* out; unsigned char* ws; float inv_freq[8]; int ph_lo, ph_hi; };
typedef const __attribute__((address_space(4))) Args* ArgsP;

__device__ __forceinline__ void transpose_item(const float* W, int Nsrc, int K, bf16* WT, int k0, int n0, int drow0, LAS float* scr, int lane, const float* kscale) {
#pragma unroll 8
    for (int i = 0; i < 32; ++i) { const int kk = 2 * i + (lane >> 5), n = n0 + (lane & 31); const float sc = kscale ? kscale[k0 + kk] : 1.0f; scr[kk * 33 + (lane & 31)] = n < Nsrc ? W[(size_t)(k0 + kk) * Nsrc + n] * sc : 0.f; }
    LDS_WAIT();
    const int c = lane & 7;
#pragma unroll
    for (int j = 0; j < 4; ++j) { const int nn = (lane >> 3) + 8 * j; const LAS float* s = scr + (8 * c) * 33 + nn;
        u32x4 o; o.x = pk2(s[0 * 33], s[1 * 33]); o.y = pk2(s[2 * 33], s[3 * 33]); o.z = pk2(s[4 * 33], s[5 * 33]); o.w = pk2(s[6 * 33], s[7 * 33]);
        *(u32x4*)(WT + (size_t)(drow0 + nn) * K + k0 + 8 * c) = o; }
    LDS_WAIT();
}

template <bool TOF32>
__device__ __forceinline__ void rms_row(const float* xrow, const float* w, void* orow, int lane) {
    const f32x4* xr = (const f32x4*)xrow + lane; const f32x4* wr = (const f32x4*)w + lane;
    f32x4 v[4]; float s = 0.f;
#pragma unroll
    for (int j = 0; j < 4; ++j) { v[j] = xr[64 * j]; s += (v[j].x * v[j].x + v[j].y * v[j].y) + (v[j].z * v[j].z + v[j].w * v[j].w); }
    const float rstd = 1.0f / sqrtf(wave_sum(s) * (1.f / 1024.f) + 1e-5f);
#pragma unroll
    for (int j = 0; j < 4; ++j) { const f32x4 ww = wr[64 * j]; const f32x4 o = v[j] * rstd * ww;
        if (TOF32) ((f32x4*)orow)[lane + 64 * j] = o;
        else { u32x2 pk; pk.x = pk2(o.x, o.y); pk.y = pk2(o.z, o.w); ((u32x2*)orow)[lane + 64 * j] = pk; } }
}

__device__ __forceinline__ void phase_prologue(ArgsP a, LAS unsigned char* lds, int wave, int lane) {
    unsigned char* ws = a->ws;
    LAS float* scr = (LAS float*)(lds + wave * 16384);
    const int gw = blockIdx.x * 8 + wave, NGW = gridDim.x * 8;
    constexpr int I_IN = 16 * 112, I_OUT = 24 * 32, I_G = 16 * 88, I_D = 44 * 32, I_LAYER = I_IN + I_OUT + 2 * I_G + I_D;
    for (int it = gw; it < 2 * I_LAYER; it += NGW) {
        const int l = it / I_LAYER; int r = it - l * I_LAYER;
        if (r < I_IN) { const int kb = r / 112, nb = r % 112; transpose_item(a->in[3] + (size_t)l * DM * NPROJ_SRC, NPROJ_SRC, DM, (bf16*)(ws + WS_WIN) + (size_t)l * NPROJ_PAD * DM, kb * 64, nb * 32, nb * 32, scr, lane, a->in[2] + (size_t)l * DM); continue; } r -= I_IN;
        if (r < I_OUT) { const int kb = r / 32, nb = r % 32; transpose_item(a->in[10] + (size_t)l * MIXW * DM, DM, MIXW, (bf16*)(ws + WS_WOUT) + (size_t)l * DM * MIXW, kb * 64, nb * 32, nb * 32, scr, lane, nullptr); continue; } r -= I_OUT;
        if (r < 2 * I_G) { const int s = r / I_G; r -= s * I_G; const int kb = r / 88, nb = r % 88, n0 = nb * 32;
            transpose_item((s ? a->in[13] : a->in[12]) + (size_t)l * DM * FFN, FFN, DM, (bf16*)(ws + WS_WGU) + (size_t)l * 2 * FFN * DM, kb * 64, n0, 256 * (n0 >> 7) + 128 * s + (n0 & 127), scr, lane, a->in[11] + (size_t)l * DM); continue; } r -= 2 * I_G;
        { const int kb = r / 32, nb = r % 32; transpose_item(a->in[14] + (size_t)l * FFN * DM, DM, FFN, (bf16*)(ws + WS_WDN) + (size_t)l * DM * FFN, kb * 64, nb * 32, nb * 32, scr, lane, nullptr); }
    }
    const int* pos = (const int*)a->in[1]; float* CS = (float*)(ws + WS_CS);
    for (int idx = gw * 64 + lane; idx < NTOK * 8; idx += NGW * 64) { const int row = idx >> 3, i = idx & 7;
        const float fr_ = i == 0 ? a->inv_freq[0] : i == 1 ? a->inv_freq[1] : i == 2 ? a->inv_freq[2] : i == 3 ? a->inv_freq[3] : i == 4 ? a->inv_freq[4] : i == 5 ? a->inv_freq[5] : i == 6 ? a->inv_freq[6] : a->inv_freq[7];
        const float ang = (float)pos[row] * fr_; const double ad = (double)ang; const double k = rint(ad * 0.15915494309189535); const float r = (float)(ad - k * 6.283185307179586);
        CS[(size_t)row * 16 + i] = __cosf(r); CS[(size_t)row * 16 + 8 + i] = __sinf(r); }
    for (int m = gw; m < NTOK; m += 2 * NGW) {
        f32x4 va[4], vb[4]; const f32x4* xa = (const f32x4*)(a->in[0] + (size_t)m * DM) + lane; const f32x4* xb = (const f32x4*)(a->in[0] + (size_t)(m + NGW) * DM) + lane;
#pragma unroll
        for (int j = 0; j < 4; ++j) { va[j] = xa[64 * j]; vb[j] = xb[64 * j]; }
#pragma unroll
        for (int h2 = 0; h2 < 2; ++h2) { const int mm = m + h2 * NGW; u32x2* o8 = (u32x2*)((bf16*)(ws + WS_XN) + (size_t)mm * DM) + lane; float ss = 0.f;
#pragma unroll
            for (int j = 0; j < 4; ++j) { const f32x4 v = h2 ? vb[j] : va[j]; ss += (v.x * v.x + v.y * v.y) + (v.z * v.z + v.w * v.w); u32x2 pk; pk.x = pk2(v.x, v.y); pk.y = pk2(v.z, v.w); o8[64 * j] = pk; }
            ss = wave_sum(ss); if (lane < 5) ((float*)(ws + WS_SSP))[(size_t)lane * NTOK + mm] = lane == 0 ? ss : 0.f; } }
}

typedef short bf16x8 __attribute__((ext_vector_type(8)));
typedef short s16x4 __attribute__((ext_vector_type(4)));
typedef float f32x16 __attribute__((ext_vector_type(16)));
constexpr int KSTR = 72, VSTR = 96;
constexpr int ATT_UNITS = 32 * 2 * 48;

__device__ __forceinline__ void attn_decode(int U, int& b, int& kvh, int& br, int& sh, int& res, int& n) {
    const int bk = U / 48, u48 = U - bk * 48; b = bk >> 1; kvh = bk & 1; br = u48 >> 4; const int idx = u48 & 15; sh = 2 * br;
    res = br == 0 ? 0 : (br == 1 ? (idx & 3) : idx); n = br == 0 ? idx : (br == 1 ? (idx >> 2) : 0);
}
__device__ __forceinline__ void attn_prefetch(const bf16* PROJ, int U, int skey, int sdc, u32x4 (&kreg)[4], u32x4 (&vreg)[4]) {
    int b, kvh, br, sh, res, n; attn_decode(U, b, kvh, br, sh, res, n);
#pragma unroll
    for (int i = 0; i < 4; ++i) { const int l = 128 * (n - 1) + skey + 64 * i;
        if (l >= 0) { const int t = (l << sh) + res; const bf16* p = PROJ + (size_t)(b * SEQ + t) * NPROJ + kvh * 64 + sdc * 8; kreg[i] = *(const u32x4*)(p + 512); vreg[i] = *(const u32x4*)(p + 640); }
        else { kreg[i] = (u32x4){0u, 0u, 0u, 0u}; vreg[i] = (u32x4){0u, 0u, 0u, 0u}; } }
}
#define TR_READ8(dst, addr, OFF0, OFF1) do { s16x4 _a, _b; asm volatile("ds_read_b64_tr_b16 %0, %2 offset:%3\n\tds_read_b64_tr_b16 %1, %2 offset:%4\n\ts_waitcnt lgkmcnt(0)" : "=&v"(_a), "=&v"(_b) : "v"(addr), "i"(OFF0), "i"(OFF1) : "memory"); \
    dst = (bf16x8){_a[0], _a[1], _a[2], _a[3], _b[0], _b[1], _b[2], _b[3]}; } while (0)

__device__ __forceinline__ void attn_mfma(ArgsP a, LAS unsigned char* lds, int tid, int wave, int lane) {
    unsigned char* ws = a->ws;
    const bf16* PROJ = (const bf16*)(ws + WS_PROJ); bf16* OA = (bf16*)a->out; bf16* OB = OA + (size_t)NTOK * 512; bf16* MIX = (bf16*)(ws + WS_MIX); float* LSE = (float*)(ws + WS_LSE);
    LAS bf16* KS = (LAS bf16*)lds; LAS bf16* VS = KS + 256 * KSTR;
    const int g = wave >> 1, qh = wave & 1, r = lane & 31, hh = lane >> 5;
    const int skey = tid >> 3, sdc = tid & 7;
    const unsigned vs_lane = (unsigned)(size_t)VS + (unsigned)((4 * hh + ((lane & 15) >> 2)) * (VSTR * 2) + (16 * ((lane >> 4) & 1) + 4 * (lane & 3)) * 2);
    u32x4 kreg[4], vreg[4];
    const int ubase = (blockIdx.x & 7) * (ATT_UNITS / 8) + (blockIdx.x >> 3);
    attn_prefetch(PROJ, ubase, skey, sdc, kreg, vreg);
    for (int ui = 0; ui < ATT_UNITS / 256; ++ui) { const int U = ubase + 32 * ui;
        int b, kvh, br, sh, res, n; attn_decode(U, b, kvh, br, sh, res, n);
        const int head = kvh * 4 + g;
        bf16x8 qa[4], qb[4];
        { const size_t rowa = (size_t)(b * SEQ + ((128 * n + 64 * qh + r) << sh) + res), rowb = (size_t)(b * SEQ + ((128 * n + 64 * qh + 32 + r) << sh) + res);
#pragma unroll
            for (int ks = 0; ks < 4; ++ks) { qa[ks] = *(const bf16x8*)(PROJ + rowa * NPROJ + head * 64 + 16 * ks + 8 * hh); qb[ks] = *(const bf16x8*)(PROJ + rowb * NPROJ + head * 64 + 16 * ks + 8 * hh); } }
        __syncthreads();
#pragma unroll
        for (int i = 0; i < 4; ++i) { const int key = skey + 64 * i; *(LAS u32x4*)(KS + key * KSTR + sdc * 8) = kreg[i]; *(LAS u32x4*)(VS + key * VSTR + sdc * 8) = vreg[i]; }
        __syncthreads();
        if (ui + 1 < ATT_UNITS / 256) attn_prefetch(PROJ, U + 32, skey, sdc, kreg, vreg);
#pragma unroll 1
        for (int qt = 0; qt < 2; ++qt) {
            const int q0 = 64 * qh + 32 * qt, kt0 = 2 * qh + qt;
            const int lq = 128 * n + q0 + r; const size_t row = (size_t)(b * SEQ + (lq << sh) + res);
            bf16x8 qf[4];
#pragma unroll
            for (int ks = 0; ks < 4; ++ks) qf[ks] = qt ? qb[ks] : qa[ks];
            f32x16 sacc[5];
            const int dq = r - 4 * hh;
#pragma unroll
            for (int k5 = 0; k5 < 5; ++k5) { f32x16 acc;
#pragma unroll
                for (int v = 0; v < 16; ++v) acc[v] = 0.f;
                const bool tile_ok = n > 0 || kt0 + k5 >= 4;
                if (tile_ok) {
#pragma unroll
                    for (int ks = 0; ks < 4; ++ks) { const bf16x8 kf = *(const LAS bf16x8*)(KS + (32 * (kt0 + k5) + r) * KSTR + 16 * ks + 8 * hh); acc = __builtin_amdgcn_mfma_f32_32x32x16_bf16(kf, qf[ks], acc, 0, 0, 0); }
                    if (k5 == 0) {
#pragma unroll
                        for (int v = 0; v < 16; ++v) acc[v] = ((v & 3) + 8 * (v >> 2) >= dq) ? acc[v] : -1e30f; }
                    if (k5 == 4) {
#pragma unroll
                        for (int v = 0; v < 16; ++v) acc[v] = ((v & 3) + 8 * (v >> 2) <= dq) ? acc[v] : -1e30f; }
                } else {
#pragma unroll
                    for (int v = 0; v < 16; ++v) acc[v] = -1e30f; }
                sacc[k5] = acc; }
            float m = -1e30f;
#pragma unroll
            for (int k5 = 0; k5 < 5; ++k5)
#pragma unroll
                for (int v = 0; v < 16; ++v) m = fmaxf(m, sacc[k5][v]);
            m = fmaxf(m, __shfl_xor(m, 32));
            float lsum = 0.f;
#pragma unroll
            for (int k5 = 0; k5 < 5; ++k5) {
                if (n > 0 || kt0 + k5 >= 4) {
#pragma unroll
                    for (int v = 0; v < 16; ++v) { const float pv = __builtin_amdgcn_exp2f(sacc[k5][v] - m); sacc[k5][v] = pv; lsum += pv; } } }
            lsum += __shfl_xor(lsum, 32);
            f32x16 oacc[2];
#pragma unroll
            for (int v = 0; v < 16; ++v) { oacc[0][v] = 0.f; oacc[1][v] = 0.f; }
#pragma unroll
            for (int k5 = 0; k5 < 5; ++k5) { const unsigned vaddr = vs_lane + (unsigned)(32 * (kt0 + k5) * (VSTR * 2));
                if (n > 0 || kt0 + k5 >= 4) { s16x4 t0, t1, t2, t3, t4, t5, t6, t7;
                    asm volatile("ds_read_b64_tr_b16 %0, %8 offset:%9\n\tds_read_b64_tr_b16 %1, %8 offset:%10\n\tds_read_b64_tr_b16 %2, %8 offset:%11\n\tds_read_b64_tr_b16 %3, %8 offset:%12\n\t"
                                 "ds_read_b64_tr_b16 %4, %8 offset:%13\n\tds_read_b64_tr_b16 %5, %8 offset:%14\n\tds_read_b64_tr_b16 %6, %8 offset:%15\n\tds_read_b64_tr_b16 %7, %8 offset:%16\n\ts_waitcnt lgkmcnt(0)"
                                 : "=&v"(t0), "=&v"(t1), "=&v"(t2), "=&v"(t3), "=&v"(t4), "=&v"(t5), "=&v"(t6), "=&v"(t7)
                                 : "v"(vaddr), "i"(0), "i"(8 * VSTR * 2), "i"(64), "i"(8 * VSTR * 2 + 64), "i"(16 * VSTR * 2), "i"(24 * VSTR * 2), "i"(16 * VSTR * 2 + 64), "i"(24 * VSTR * 2 + 64) : "memory");
                    const bf16x8 va0 = {t0[0], t0[1], t0[2], t0[3], t1[0], t1[1], t1[2], t1[3]}, va1 = {t2[0], t2[1], t2[2], t2[3], t3[0], t3[1], t3[2], t3[3]};
                    const bf16x8 vb0 = {t4[0], t4[1], t4[2], t4[3], t5[0], t5[1], t5[2], t5[3]}, vb1 = {t6[0], t6[1], t6[2], t6[3], t7[0], t7[1], t7[2], t7[3]};
                    u32x4 pw;
                    pw.x = pg8::cvt_pk_bf16(sacc[k5][0], sacc[k5][1]); pw.y = pg8::cvt_pk_bf16(sacc[k5][2], sacc[k5][3]); pw.z = pg8::cvt_pk_bf16(sacc[k5][4], sacc[k5][5]); pw.w = pg8::cvt_pk_bf16(sacc[k5][6], sacc[k5][7]);
                    const bf16x8 pf0 = __builtin_bit_cast(bf16x8, pw);
                    pw.x = pg8::cvt_pk_bf16(sacc[k5][8], sacc[k5][9]); pw.y = pg8::cvt_pk_bf16(sacc[k5][10], sacc[k5][11]); pw.z = pg8::cvt_pk_bf16(sacc[k5][12], sacc[k5][13]); pw.w = pg8::cvt_pk_bf16(sacc[k5][14], sacc[k5][15]);
                    const bf16x8 pf1 = __builtin_bit_cast(bf16x8, pw);
                    oacc[0] = __builtin_amdgcn_mfma_f32_32x32x16_bf16(va0, pf0, oacc[0], 0, 0, 0);
                    oacc[1] = __builtin_amdgcn_mfma_f32_32x32x16_bf16(va1, pf0, oacc[1], 0, 0, 0);
                    oacc[0] = __builtin_amdgcn_mfma_f32_32x32x16_bf16(vb0, pf1, oacc[0], 0, 0, 0);
                    oacc[1] = __builtin_amdgcn_mfma_f32_32x32x16_bf16(vb1, pf1, oacc[1], 0, 0, 0); } }
            const float linv = 1.0f / lsum;
            bf16* obase = br == 0 ? OA + row * 512 : (br == 1 ? OB + row * 512 : MIX + row * MIXW);
            obase += head * 64 + 4 * hh;
#pragma unroll
            for (int dt = 0; dt < 2; ++dt)
#pragma unroll
                for (int b4 = 0; b4 < 4; ++b4) { u32x2 w; w.x = pg8::cvt_pk_bf16(oacc[dt][4 * b4 + 0] * linv, oacc[dt][4 * b4 + 1] * linv); w.y = pg8::cvt_pk_bf16(oacc[dt][4 * b4 + 2] * linv, oacc[dt][4 * b4 + 3] * linv);
                    *(u32x2*)(obase + 32 * dt + 8 * b4) = w; }
            if (hh == 0) LSE[((size_t)br * NTOK + row) * 8 + head] = m + __builtin_amdgcn_logf(lsum);
        }
    }
    __syncthreads();
}

#define MFMA16(a_, b_, c_) __builtin_amdgcn_mfma_f32_16x16x32_bf16(a_, b_, c_, 0, 0, 0)
constexpr int BSTR = 144, CSTR = 136, GSTR = 136, XSTR = 136;
#define TR16_READ8(dst, addr, OFF0, OFF1) do { s16x4 _a, _b; asm volatile("ds_read_b64_tr_b16 %0, %2 offset:%3\n\tds_read_b64_tr_b16 %1, %2 offset:%4\n\ts_waitcnt lgkmcnt(0)" : "=&v"(_a), "=&v"(_b) : "v"(addr), "i"(OFF0), "i"(OFF1) : "memory"); \
    dst = (bf16x8){_a[0], _a[1], _a[2], _a[3], _b[0], _b[1], _b[2], _b[3]}; } while (0)
__device__ __forceinline__ float bflo(unsigned w) { return __uint_as_float(w << 16); }
__device__ __forceinline__ float bfhi(unsigned w) { return __uint_as_float(w & 0xffff0000u); }

__device__ __forceinline__ void ssd_s0_load(const bf16* PROJ, const float* DT, int b, int hp, int g, int tc, int pair, u32x4 (&raw)[11], float (&dtv)[8]) {
    const int seg = pair / 48, cc = pair - seg * 48, tb = tc + seg * 8;
    const int col = cc < 16 ? 1792 + hp * 128 + cc * 8 : (cc < 32 ? 2816 + g * 128 + (cc - 16) * 8 : 3072 + g * 128 + (cc - 32) * 8);
#pragma unroll
    for (int i = 0; i < 11; ++i) { const int t = tb - 3 + i; raw[i] = (u32x4){0u, 0u, 0u, 0u}; if (t >= 0) raw[i] = *(const u32x4*)(PROJ + (size_t)(b * SEQ + t) * NPROJ + col); }
#pragma unroll
    for (int i = 0; i < 8; ++i) dtv[i] = cc < 16 ? DT[(size_t)(b * SEQ + tb + i) * 16 + 2 * hp + (cc >> 3)] : 1.0f;
}
__device__ __forceinline__ void ssd_s0_compute(const float* conv_w, const float* conv_b, int hp, int g, int pair, const u32x4 (&raw)[11], const float (&dtv)[8], LAS bf16* BS, LAS bf16* CS_, LAS bf16* XT) {
    const int seg = pair / 48, cc = pair - seg * 48;
    const int xch = cc < 16 ? hp * 128 + cc * 8 : (cc < 32 ? 1024 + g * 128 + (cc - 16) * 8 : 1280 + g * 128 + (cc - 32) * 8);
    u32x4 ot[8];
#pragma unroll
    for (int jp = 0; jp < 4; ++jp) {
        float w0[4], w1[4];
#pragma unroll
        for (int k = 0; k < 4; ++k) { w0[k] = conv_w[k * CONVCH + xch + 2 * jp]; w1[k] = conv_w[k * CONVCH + xch + 2 * jp + 1]; }
        const float b0 = conv_b[xch + 2 * jp], b1 = conv_b[xch + 2 * jp + 1];
#pragma unroll
        for (int i = 0; i < 8; ++i) { float a0 = b0, a1 = b1;
#pragma unroll
            for (int k = 0; k < 4; ++k) { a0 += w0[k] * bflo(raw[i + k][jp]); a1 += w1[k] * bfhi(raw[i + k][jp]); }
            ot[i][jp] = pg8::cvt_pk_bf16(silu(a0) * dtv[i], silu(a1) * dtv[i]); } }
    if (cc < 16) { const int eh = cc >> 3, p0 = (cc & 7) * 8;
#pragma unroll
        for (int jp = 0; jp < 4; ++jp) { u32x4 lo, hi;
#pragma unroll
            for (int k = 0; k < 4; ++k) { lo[k] = (ot[2 * k][jp] & 0xffffu) | (ot[2 * k + 1][jp] << 16); hi[k] = (ot[2 * k][jp] >> 16) | (ot[2 * k + 1][jp] & 0xffff0000u); }
            *(LAS u32x4*)(XT + (eh * 64 + p0 + 2 * jp) * XSTR + seg * 8) = lo; *(LAS u32x4*)(XT + (eh * 64 + p0 + 2 * jp + 1) * XSTR + seg * 8) = hi; } }
    else if (cc < 32) {
#pragma unroll
        for (int i = 0; i < 8; ++i) *(LAS u32x4*)(BS + (seg * 8 + i) * BSTR + (cc - 16) * 8) = ot[i]; }
    else {
#pragma unroll
        for (int i = 0; i < 8; ++i) *(LAS u32x4*)(CS_ + (seg * 8 + i) * CSTR + (cc - 32) * 8) = ot[i]; }
}

__device__ __forceinline__ void cbc_load(const bf16* PROJ, int it, u32x4 (&raw)[11]) {
    const int cc = it & 63, row0 = (it >> 6) * 8, tseq = row0 & (SEQ - 1); const bf16* src = PROJ + (size_t)row0 * NPROJ + 2816 + cc * 8;
#pragma unroll
    for (int i = 0; i < 11; ++i) { raw[i] = (u32x4){0u, 0u, 0u, 0u}; if (tseq - 3 + i >= 0) raw[i] = *(const u32x4*)(src + (ptrdiff_t)(i - 3) * NPROJ); }
}
__device__ __forceinline__ void cbc_compute(const float* conv_w, const float* conv_b, bf16* CBC, int it, const u32x4 (&raw)[11]) {
    const int cc = it & 63, row0 = (it >> 6) * 8, xch = 1024 + cc * 8;
    u32x4 ot[8];
#pragma unroll
    for (int jp = 0; jp < 4; ++jp) {
        float w0[4], w1[4];
#pragma unroll
        for (int k = 0; k < 4; ++k) { w0[k] = conv_w[k * CONVCH + xch + 2 * jp]; w1[k] = conv_w[k * CONVCH + xch + 2 * jp + 1]; }
        const float b0 = conv_b[xch + 2 * jp], b1 = conv_b[xch + 2 * jp + 1];
#pragma unroll
        for (int i = 0; i < 8; ++i) { float a0 = b0, a1 = b1;
#pragma unroll
            for (int k = 0; k < 4; ++k) { a0 += w0[k] * bflo(raw[i + k][jp]); a1 += w1[k] * bfhi(raw[i + k][jp]); }
            ot[i][jp] = pg8::cvt_pk_bf16(silu(a0), silu(a1)); } }
#pragma unroll
    for (int i = 0; i < 8; ++i) *(u32x4*)(CBC + (size_t)(row0 + i) * 512 + cc * 8) = ot[i];
}
__device__ __forceinline__ void cbc_prepass(ArgsP a, int layer, int tid) {
    unsigned char* ws = a->ws; const bf16* PROJ = (const bf16*)(ws + WS_PROJ); bf16* CBC = (bf16*)(ws + WS_CBC);
    const float* conv_w = a->in[4] + (size_t)layer * 4 * CONVCH; const float* conv_b = a->in[5] + (size_t)layer * CONVCH;
    const int nth = gridDim.x * 512;
#pragma unroll 1
    for (int it = blockIdx.x * 512 + tid; it < (NTOK / 8) * 64; it += 2 * nth) {
        u32x4 rawA[11], rawB[11]; cbc_load(PROJ, it, rawA); cbc_load(PROJ, it + nth, rawB);
        cbc_compute(conv_w, conv_b, CBC, it, rawA); cbc_compute(conv_w, conv_b, CBC, it + nth, rawB); }
}

__device__ __forceinline__ void ssd_mfma(ArgsP a, int layer, LAS unsigned char* lds, int tid, int wave, int lane) {
    unsigned char* ws = a->ws;
    const bf16* PROJ = (const bf16*)(ws + WS_PROJ); bf16* MIX = (bf16*)(ws + WS_MIX); const float* DT = (const float*)(ws + WS_DT); float* SSQ4 = (float*)(ws + WS_SSQ);
    const bf16* CBC = (const bf16*)(ws + WS_CBC);
    const float* conv_w = a->in[4] + (size_t)layer * 4 * CONVCH; const float* conv_b = a->in[5] + (size_t)layer * CONVCH;
    LAS bf16* BS = (LAS bf16*)lds; LAS bf16* CS_ = BS + 128 * BSTR; LAS bf16* MS = CS_ + 128 * CSTR; LAS bf16* XT = MS + 2 * 9216;
    LAS float* CSUM = (LAS float*)(XT + 2 * 64 * XSTR); LAS float* DTS = CSUM + 256;
    const int e = wave >> 2, pq = wave & 3, c16 = lane & 15, q = lane >> 4;
    const unsigned bs_tr = (unsigned)(size_t)BS + (unsigned)((8 * q + ((lane & 15) >> 2)) * (BSTR * 2) + 4 * (lane & 3) * 2);
    for (int item = blockIdx.x; item < 256; item += gridDim.x) {
        const int b = (item & 7) * 4 + (item >> 6), hp = (item >> 3) & 7, g = hp >> 2, hh = 2 * hp + e;
        const float A = -__expf(a->in[7][layer * 16 + hh]), Dk0 = a->in[8][layer * 16 + 2 * hp], Dk1 = a->in[8][layer * 16 + 2 * hp + 1];
        f32x4 st[8];
#pragma unroll
        for (int i = 0; i < 8; ++i) st[i] = (f32x4){0.f, 0.f, 0.f, 0.f};
        const int xpair = (tid >> 4) * 48 + (tid & 15);
        u32x4 rawN[11]; float dtN[8];
        if (tid < 256) ssd_s0_load(PROJ, DT, b, hp, g, 0, xpair, rawN, dtN);
#pragma unroll 1
        for (int c = 0; c < 16; ++c) {
            const int tc = c * 128;
            if (pq == 0) { const int l0 = 2 * lane; const float d0 = DT[(size_t)(b * SEQ + tc + l0) * 16 + hh], d1 = DT[(size_t)(b * SEQ + tc + l0 + 1) * 16 + hh];
                const float a0 = d0 * A, a1 = d1 * A; float s = a0 + a1;
#pragma unroll
                for (int o = 1; o < 64; o <<= 1) { const float t = __shfl_up(s, o); if (lane >= o) s += t; }
                CSUM[e * 128 + l0] = s - a1; CSUM[e * 128 + l0 + 1] = s; DTS[e * 128 + l0] = d0; DTS[e * 128 + l0 + 1] = d1; }
            if (tid < 256) ssd_s0_compute(conv_w, conv_b, hp, g, xpair, rawN, dtN, BS, CS_, XT);
            else {
                const int j = tid - 256; const bf16* cb = CBC + (size_t)(b * SEQ + tc) * 512 + g * 128;
#pragma unroll 1
                for (int hb2 = 0; hb2 < 4; ++hb2) { u32x4 cv[4];
#pragma unroll
                    for (int i = 0; i < 4; ++i) { const int id = j + 256 * (4 * hb2 + i), row = id >> 5, cj = id & 31; cv[i] = *(const u32x4*)(cb + (size_t)row * 512 + (cj < 16 ? cj * 8 : 256 + (cj - 16) * 8)); }
#pragma unroll
                    for (int i = 0; i < 4; ++i) { const int id = j + 256 * (4 * hb2 + i), row = id >> 5, cj = id & 31;
                        if (cj < 16) *(LAS u32x4*)(BS + row * BSTR + cj * 8) = cv[i]; else *(LAS u32x4*)(CS_ + row * CSTR + (cj - 16) * 8) = cv[i]; } } }
            __syncthreads();
#pragma unroll 1
            for (int idx = wave; idx < 36; idx += 8) { int lt = 0; while ((lt + 1) * (lt + 2) / 2 <= idx) ++lt; const int stl = idx - lt * (lt + 1) / 2;
                f32x4 acc = {0.f, 0.f, 0.f, 0.f};
#pragma unroll
                for (int ks = 0; ks < 4; ++ks) { const bf16x8 af = *(const LAS bf16x8*)(BS + (16 * stl + c16) * BSTR + 32 * ks + 8 * q), bfr = *(const LAS bf16x8*)(CS_ + (16 * lt + c16) * CSTR + 32 * ks + 8 * q); acc = MFMA16(af, bfr, acc); }
                const int l = 16 * lt + c16, s0 = 16 * stl + 4 * q;
#pragma unroll
                for (int eh = 0; eh < 2; ++eh) { const float csl = CSUM[eh * 128 + l]; const f32x4 cs4 = *(const LAS f32x4*)(CSUM + eh * 128 + s0); const float dsk = (eh ? Dk1 : Dk0) / DTS[eh * 128 + l];
                    float mv[4];
#pragma unroll
                    for (int ee = 0; ee < 4; ++ee) { const int sidx = s0 + ee; const float v = acc[ee] * __expf(csl - cs4[ee]); mv[ee] = sidx < l ? v : (sidx == l ? acc[ee] + dsk : 0.f); }
                    u32x2 w; w.x = pk2(mv[0], mv[1]); w.y = pk2(mv[2], mv[3]);
                    *(LAS u32x2*)(MS + eh * 9216 + idx * 256 + c16 * 16 + 4 * q) = w; } }
            __syncthreads();
            u32x2 zr[8];
#pragma unroll
            for (int lt = 0; lt < 8; ++lt) zr[lt] = *(const u32x2*)(PROJ + (size_t)(b * SEQ + tc + 16 * lt + c16) * NPROJ + 768 + hh * 64 + 16 * pq + 4 * q);
            bf16x8 hb[4];
#pragma unroll
            for (int ks = 0; ks < 4; ++ks) { u32x4 w; w.x = pg8::cvt_pk_bf16(st[2 * ks][0], st[2 * ks][1]); w.y = pg8::cvt_pk_bf16(st[2 * ks][2], st[2 * ks][3]); w.z = pg8::cvt_pk_bf16(st[2 * ks + 1][0], st[2 * ks + 1][1]); w.w = pg8::cvt_pk_bf16(st[2 * ks + 1][2], st[2 * ks + 1][3]); hb[ks] = __builtin_bit_cast(bf16x8, w); }
            const LAS float* csh = CSUM + e * 128;
            const LAS bf16* ms_lane = MS + e * 9216 + (q >> 1) * 256 + c16 * 16 + (q & 1) * 8;
            const float cs_end = csh[127];
#pragma unroll
            for (int lt = 0; lt < 8; ++lt) { const int l = 16 * lt + c16; const float csl = csh[l];
                f32x4 acc = {0.f, 0.f, 0.f, 0.f};
#pragma unroll
                for (int ks = 0; ks < 4; ++ks) { const u32x2 c0 = *(const LAS u32x2*)(CS_ + l * CSTR + 32 * ks + 4 * q), c1 = *(const LAS u32x2*)(CS_ + l * CSTR + 32 * ks + 16 + 4 * q);
                    const u32x4 cw = {c0.x, c0.y, c1.x, c1.y}; acc = MFMA16(hb[ks], __builtin_bit_cast(bf16x8, cw), acc); }
                const float el = __expf(csl); acc = acc * el;
#pragma unroll
                for (int ks = 0; ks < 4; ++ks) if (ks <= (lt >> 1)) { const int s0 = 32 * ks + 8 * q;
                    u32x4 mw = *(const LAS u32x4*)(ms_lane + (lt * (lt + 1) / 2 + 2 * ks) * 256);
                    if ((lt & 1) == 0 && ks == (lt >> 1)) { if (q >= 2) mw = (u32x4){0u, 0u, 0u, 0u}; }
                    const bf16x8 xa = *(const LAS bf16x8*)(XT + (e * 64 + 16 * pq + c16) * XSTR + s0);
                    acc = MFMA16(xa, __builtin_bit_cast(bf16x8, mw), acc); }
                const size_t row = (size_t)(b * SEQ + tc + l);
                const float y0 = acc[0] * silu(bflo(zr[lt].x)), y1 = acc[1] * silu(bfhi(zr[lt].x)), y2 = acc[2] * silu(bflo(zr[lt].y)), y3 = acc[3] * silu(bfhi(zr[lt].y));
                u32x2 ow; ow.x = pg8::cvt_pk_bf16(y0, y1); ow.y = pg8::cvt_pk_bf16(y2, y3);
                *(u32x2*)(MIX + row * MIXW + 512 + hh * 64 + 16 * pq + 4 * q) = ow;
                float ss = (y0 * y0 + y1 * y1) + (y2 * y2 + y3 * y3); ss += __shfl_xor(ss, 16); ss += __shfl_xor(ss, 32);
                if (q == 0) SSQ4[(row * 16 + hh) * 4 + pq] = ss; }
            if (tid < 256) ssd_s0_load(PROJ, DT, b, hp, g, c + 1 < 16 ? tc + 128 : tc, xpair, rawN, dtN);
            { const float dall = __expf(cs_end);
#pragma unroll
                for (int nt = 0; nt < 8; ++nt) st[nt] = st[nt] * dall;
#pragma unroll
                for (int ks = 0; ks < 4; ++ks) { const int l0 = 32 * ks + 8 * q;
                    const u32x4 xw = *(const LAS u32x4*)(XT + (e * 64 + 16 * pq + c16) * XSTR + l0); const f32x4 ca = *(const LAS f32x4*)(csh + l0), cb = *(const LAS f32x4*)(csh + l0 + 4);
                    u32x4 dw;
                    dw.x = pg8::cvt_pk_bf16(bflo(xw.x) * __expf(cs_end - ca.x), bfhi(xw.x) * __expf(cs_end - ca.y)); dw.y = pg8::cvt_pk_bf16(bflo(xw.y) * __expf(cs_end - ca.z), bfhi(xw.y) * __expf(cs_end - ca.w));
                    dw.z = pg8::cvt_pk_bf16(bflo(xw.z) * __expf(cs_end - cb.x), bfhi(xw.z) * __expf(cs_end - cb.y)); dw.w = pg8::cvt_pk_bf16(bflo(xw.w) * __expf(cs_end - cb.z), bfhi(xw.w) * __expf(cs_end - cb.w));
                    const bf16x8 xd = __builtin_bit_cast(bf16x8, dw);
                    const unsigned ba = bs_tr + (unsigned)(32 * ks * (BSTR * 2));
#define SSD_RD4(n0) { s16x4 t0, t1, t2, t3, t4, t5, t6, t7; \
                        asm volatile("ds_read_b64_tr_b16 %0, %8 offset:%9\n\tds_read_b64_tr_b16 %1, %8 offset:%10\n\tds_read_b64_tr_b16 %2, %8 offset:%11\n\tds_read_b64_tr_b16 %3, %8 offset:%12\n\t" \
                                     "ds_read_b64_tr_b16 %4, %8 offset:%13\n\tds_read_b64_tr_b16 %5, %8 offset:%14\n\tds_read_b64_tr_b16 %6, %8 offset:%15\n\tds_read_b64_tr_b16 %7, %8 offset:%16\n\ts_waitcnt lgkmcnt(0)" \
                                     : "=&v"(t0), "=&v"(t1), "=&v"(t2), "=&v"(t3), "=&v"(t4), "=&v"(t5), "=&v"(t6), "=&v"(t7) \
                                     : "v"(ba), "i"((n0) * 32), "i"(4 * BSTR * 2 + (n0) * 32), "i"((n0) * 32 + 32), "i"(4 * BSTR * 2 + (n0) * 32 + 32), "i"((n0) * 32 + 64), "i"(4 * BSTR * 2 + (n0) * 32 + 64), "i"((n0) * 32 + 96), "i"(4 * BSTR * 2 + (n0) * 32 + 96) : "memory"); \
                        st[(n0) + 0] = MFMA16(((bf16x8){t0[0], t0[1], t0[2], t0[3], t1[0], t1[1], t1[2], t1[3]}), xd, st[(n0) + 0]); \
                        st[(n0) + 1] = MFMA16(((bf16x8){t2[0], t2[1], t2[2], t2[3], t3[0], t3[1], t3[2], t3[3]}), xd, st[(n0) + 1]); \
                        st[(n0) + 2] = MFMA16(((bf16x8){t4[0], t4[1], t4[2], t4[3], t5[0], t5[1], t5[2], t5[3]}), xd, st[(n0) + 2]); \
                        st[(n0) + 3] = MFMA16(((bf16x8){t6[0], t6[1], t6[2], t6[3], t7[0], t7[1], t7[2], t7[3]}), xd, st[(n0) + 3]); }
                    SSD_RD4(0) SSD_RD4(4)
#undef SSD_RD4
                } }
            __syncthreads();
        }
    }
}

struct FixRow { u32x4 y0, y1, x0, x1, x2; float ssq, l0, l1, l2; };
__device__ __forceinline__ void fix_load(FixRow& R, const bf16* MIX, const float* SSQ, const bf16* OA, const bf16* OB, const float* LSE, int row, int lane) {
    const int g = lane >> 5, head = lane >> 3; float ssq = 0.f;
#pragma unroll
    for (int i = 0; i < 8; ++i) { const f32x4 qv = *(const f32x4*)(SSQ + (size_t)row * 64 + 32 * g + 4 * i); ssq += (qv.x + qv.y) + (qv.z + qv.w); }
    R.ssq = ssq;
    const u32x4* mp = (const u32x4*)(MIX + (size_t)row * MIXW + 512 + lane * 16); R.y0 = mp[0]; R.y1 = mp[1];
    R.l0 = LSE[(size_t)row * 8 + head]; R.l1 = LSE[((size_t)NTOK + row) * 8 + head]; R.l2 = LSE[((size_t)2 * NTOK + row) * 8 + head];
    R.x0 = *(const u32x4*)(OA + (size_t)row * 512 + lane * 8); R.x1 = *(const u32x4*)(OB + (size_t)row * 512 + lane * 8); R.x2 = *(const u32x4*)(MIX + (size_t)row * MIXW + lane * 8);
}
__device__ __forceinline__ void fix_store(const FixRow& R, bf16* MIX, const f32x4 (&wv)[4], int row, int lane) {
    const float rstd = 1.0f / sqrtf(R.ssq * (1.f / 512.f) + 1e-5f);
    u32x4* mp = (u32x4*)(MIX + (size_t)row * MIXW + 512 + lane * 16);
#pragma unroll
    for (int hlf = 0; hlf < 2; ++hlf) { const u32x4 v = hlf ? R.y1 : R.y0; const f32x4 wa = wv[2 * hlf], wb = wv[2 * hlf + 1]; u32x4 o;
        o.x = pk2(__uint_as_float(v.x << 16) * rstd * wa.x, __uint_as_float(v.x & 0xffff0000u) * rstd * wa.y);
        o.y = pk2(__uint_as_float(v.y << 16) * rstd * wa.z, __uint_as_float(v.y & 0xffff0000u) * rstd * wa.w);
        o.z = pk2(__uint_as_float(v.z << 16) * rstd * wb.x, __uint_as_float(v.z & 0xffff0000u) * rstd * wb.y);
        o.w = pk2(__uint_as_float(v.w << 16) * rstd * wb.z, __uint_as_float(v.w & 0xffff0000u) * rstd * wb.w);
        mp[hlf] = o; }
    const float mx = fmaxf(R.l0, fmaxf(R.l1, R.l2)); float w0 = __builtin_amdgcn_exp2f(R.l0 - mx), w1 = __builtin_amdgcn_exp2f(R.l1 - mx), w2 = __builtin_amdgcn_exp2f(R.l2 - mx); const float wi = 1.0f / (w0 + w1 + w2); w0 *= wi; w1 *= wi; w2 *= wi;
    const u32x4 x0 = R.x0, x1 = R.x1, x2 = R.x2; u32x4 o;
#define MRG(c) pk2(w0 * __uint_as_float(x0.c << 16) + w1 * __uint_as_float(x1.c << 16) + w2 * __uint_as_float(x2.c << 16), w0 * __uint_as_float(x0.c & 0xffff0000u) + w1 * __uint_as_float(x1.c & 0xffff0000u) + w2 * __uint_as_float(x2.c & 0xffff0000u))
    o.x = MRG(x); o.y = MRG(y); o.z = MRG(z); o.w = MRG(w);
#undef MRG
    *(u32x4*)(MIX + (size_t)row * MIXW + lane * 8) = o;
}
__device__ __forceinline__ void phase_fixup(ArgsP a, int layer, int wave, int lane) {
    unsigned char* ws = a->ws; bf16* MIX = (bf16*)(ws + WS_MIX); const float* SSQ = (const float*)(ws + WS_SSQ); const float* w = a->in[9] + (size_t)layer * 1024;
    const bf16* OA = (const bf16*)a->out; const bf16* OB = OA + (size_t)NTOK * 512; const float* LSE = (const float*)(ws + WS_LSE);
    const int gw = blockIdx.x * 8 + wave, NGW = gridDim.x * 8;
    f32x4 wv[4];
#pragma unroll
    for (int i = 0; i < 4; ++i) wv[i] = *(const f32x4*)(w + lane * 16 + 4 * i);
    for (int row = gw; row < NTOK; row += 4 * NGW) {
        FixRow A, B, C, D; fix_load(A, MIX, SSQ, OA, OB, LSE, row, lane); fix_load(B, MIX, SSQ, OA, OB, LSE, row + NGW, lane); fix_load(C, MIX, SSQ, OA, OB, LSE, row + 2 * NGW, lane); fix_load(D, MIX, SSQ, OA, OB, LSE, row + 3 * NGW, lane);
        fix_store(A, MIX, wv, row, lane); fix_store(B, MIX, wv, row + NGW, lane); fix_store(C, MIX, wv, row + 2 * NGW, lane); fix_store(D, MIX, wv, row + 3 * NGW, lane); }
}

__device__ __forceinline__ void dt_side(ArgsP a, int layer, const float* SS, int wave, int lane) {
    unsigned char* ws = a->ws; const bf16* XN = (const bf16*)(ws + WS_XN); const bf16* Wdt = (const bf16*)(ws + WS_WIN) + ((size_t)layer * NPROJ_PAD + NPROJ) * DM; float* DT = (float*)(ws + WS_DT);
    const int c16 = lane & 15, q = lane >> 4, rowbase = blockIdx.x * 256 + wave * 32;
    const float bias = a->in[6][layer * 16 + c16];
    float rsv[2][4];
#pragma unroll
    for (int lt = 0; lt < 2; ++lt)
#pragma unroll
        for (int e = 0; e < 4; ++e) rsv[lt][e] = SS[rowbase + 16 * lt + 4 * q + e];
    f32x4 acc0 = {0.f, 0.f, 0.f, 0.f}, acc1 = acc0;
    const bf16* a0p = XN + (size_t)(rowbase + c16) * DM + 8 * q; const bf16* a1p = a0p + (size_t)16 * DM; const bf16* bp = Wdt + (size_t)c16 * DM + 8 * q;
#pragma unroll 8
    for (int ks = 0; ks < 32; ++ks) { const bf16x8 fa0 = *(const bf16x8*)(a0p + 32 * ks), fa1 = *(const bf16x8*)(a1p + 32 * ks), fb = *(const bf16x8*)(bp + 32 * ks);
        acc0 = MFMA16(fa0, fb, acc0); acc1 = MFMA16(fa1, fb, acc1); }
#pragma unroll
    for (int lt = 0; lt < 2; ++lt)
#pragma unroll
        for (int e = 0; e < 4; ++e) { const int row = rowbase + 16 * lt + 4 * q + e; const float rs = 1.0f / sqrtf(rsv[lt][e] * (1.f / 1024.f) + 1e-5f);
            float v = (lt ? acc1[e] : acc0[e]) * rs + bias; v = v > 20.f ? v : fmaxf(log1pf(__expf(v)), 1e-30f);
            DT[(size_t)row * 16 + c16] = v; }
}

#define XB_TMO      128
#define XB_XCNT(j)  (256  + 64 * (j))
#define XB_XSUB(j)  (1280 + 64 * (j))
#define XB_XGEN(j)  (2304 + 64 * (j))
#define XB_TOP      3328
#define XB_TOPGEN   3392
#define XCD_BAR_WORDS 3456
#define XB_SPIN_CAP (1u << 18)

__device__ __forceinline__ unsigned xb_ld(unsigned* p)              { return __hip_atomic_load(p, __ATOMIC_RELAXED, __HIP_MEMORY_SCOPE_AGENT); }
__device__ __forceinline__ unsigned xb_add(unsigned* p, unsigned v) { return __hip_atomic_fetch_add(p, v, __ATOMIC_RELAXED, __HIP_MEMORY_SCOPE_AGENT); }
__device__ __forceinline__ unsigned xb_xcc_id() { return (unsigned)__builtin_amdgcn_s_getreg((3 << 11) | 20) & 0xFu; }
#define XB_SPIN(cond, bar) do { unsigned _sp = 0; while (cond) { __builtin_amdgcn_s_sleep(1); \
    if ((++_sp & 255u) == 0u) { if (xb_ld(&(bar)[XB_TMO])) break; if (_sp > XB_SPIN_CAP) { atomicAdd(&(bar)[XB_TMO], 1u); break; } } } } while (0)

struct XcdBarrier {
    unsigned* bar; unsigned x;
    volatile LAS unsigned* st;
};

__device__ __forceinline__ XcdBarrier xcd_barrier_post(unsigned* bar, volatile LAS unsigned* st) {
    XcdBarrier b; b.bar = bar; b.x = xb_xcc_id(); b.st = st;
    if (threadIdx.x == 0) (void)xb_add(&bar[XB_XCNT(b.x)], 1u);
    return b;
}
__device__ __forceinline__ void xcd_barrier_complete(unsigned* bar, unsigned x, unsigned& nloc, unsigned& nx) {
    const unsigned G = gridDim.x * gridDim.y * gridDim.z;
    unsigned sum, cnt, mine, sp = 0u;
    for (;;) {
        sum = 0u; cnt = 0u; mine = 0u;
#pragma unroll
        for (unsigned j = 0; j < 16; ++j) { const unsigned c = xb_ld(&bar[XB_XCNT(j)]); sum += c; cnt += (c > 0u) ? 1u : 0u; mine = (j == x) ? c : mine; }
        if (sum == G) break;
        __builtin_amdgcn_s_sleep(1);
        if ((++sp & 255u) == 0u) { if (xb_ld(&bar[XB_TMO])) break; if (sp > XB_SPIN_CAP) { atomicAdd(&bar[XB_TMO], 1u); break; } }
    }
    nloc = mine > 0u ? mine : 1u; nx = cnt > 0u ? cnt : 1u;
}

__device__ __forceinline__ void xcd_barrier(const XcdBarrier& b) {
    asm volatile("s_waitcnt vmcnt(0)" ::: "memory");
    __syncthreads();
    if (threadIdx.x == 0) {
        unsigned* bar = b.bar;
        __builtin_amdgcn_s_waitcnt(0);
        unsigned nloc = b.st[0], nx = b.st[1];
        if (nloc == 0u) { xcd_barrier_complete(bar, b.x, nloc, nx); b.st[0] = nloc; b.st[1] = nx; }
        const unsigned old = xb_add(&bar[XB_XSUB(b.x)], 1u);
        const unsigned gen = old / nloc;
        if (old + 1u == (gen + 1u) * nloc) {
            __builtin_amdgcn_fence(__ATOMIC_RELEASE, "agent");
            asm volatile("s_waitcnt vmcnt(0)" ::: "memory");
            const unsigned og = xb_add(&bar[XB_TOP], 1u);
            const unsigned tg = og / nx;
            if (og + 1u == (tg + 1u) * nx) xb_add(&bar[XB_TOPGEN], 1u);
            else XB_SPIN(xb_ld(&bar[XB_TOPGEN]) == tg, bar);
            __builtin_amdgcn_fence(__ATOMIC_ACQUIRE, "agent");
            xb_add(&bar[XB_XGEN(b.x)], 1u);
            asm volatile("s_waitcnt vmcnt(0)" ::: "memory");
        } else {
            XB_SPIN(xb_ld(&bar[XB_XGEN(b.x)]) == gen, bar);
            __builtin_amdgcn_fence(__ATOMIC_ACQUIRE, "agent");
            asm volatile("s_waitcnt vmcnt(0)" ::: "memory");
        }
    }
    __syncthreads();
}

__global__ void __launch_bounds__(512, 2) fwd_kernel(Args a_by_value) {
    extern __shared__ __attribute__((aligned(16))) unsigned char lds_raw[];
    LAS unsigned char* lds = (LAS unsigned char*)lds_raw;
    ArgsP a0 = (ArgsP)__builtin_amdgcn_kernarg_segment_ptr();
    cg::grid_group grid = cg::this_grid();
    const int G = gridDim.x;
    volatile LAS unsigned* bar_st = (volatile LAS unsigned*)(lds + LDS_BYTES - 16);
    if (threadIdx.x < 2) bar_st[threadIdx.x] = 0u;
    __syncthreads();
    XcdBarrier bar = xcd_barrier_post((unsigned*)a0->ws, bar_st);
    const int ph_lo = a0->ph_lo, ph_hi = a0->ph_hi;
    for (int ph = ph_lo; ph < ph_hi; ++ph) {
        ArgsP a = a0; asm volatile("" : "+s"(a));
        unsigned char* ws = a->ws;
        int tid = threadIdx.x; asm volatile("" : "+v"(tid));
        const int lane = tid & 63, wave = __builtin_amdgcn_readfirstlane(tid >> 6);
        float* SSP = (float*)(ws + WS_SSP);
        if (ph == 0) { if (PHM & 1) phase_prologue(a, lds, wave, lane); }
        else if (ph == NPHASE - 1) {
            const int gw = blockIdx.x * 8 + wave, NGW = G * 8; const float* sp = SSP + (size_t)4 * NTOK; const float* w = a->in[15]; float* out = a->out;
            const bf16* hbf = (const bf16*)(ws + WS_XN);
            f32x4 wq[4];
#pragma unroll
            for (int j = 0; j < 2; ++j) { wq[2 * j] = ((const f32x4*)w)[2 * lane + 128 * j]; wq[2 * j + 1] = ((const f32x4*)w)[2 * lane + 128 * j + 1]; }
            for (int m = gw; m < NTOK; m += 2 * NGW) {
                const float s0 = sp[m], s1 = sp[m + NGW]; u32x4 hv[2][2];
#pragma unroll
                for (int h2 = 0; h2 < 2; ++h2)
#pragma unroll
                    for (int j = 0; j < 2; ++j) hv[h2][j] = ((const u32x4*)(hbf + (size_t)(m + h2 * NGW) * DM))[lane + 64 * j];
#pragma unroll
                for (int h2 = 0; h2 < 2; ++h2) { const float rstd = 1.0f / sqrtf((h2 ? s1 : s0) * (1.f / 1024.f) + 1e-5f); f32x4* xr = (f32x4*)(out + (size_t)(m + h2 * NGW) * DM) + 2 * lane;
#pragma unroll
                    for (int j = 0; j < 2; ++j) { const u32x4 h = hv[h2][j]; const f32x4 wa = wq[2 * j], wb = wq[2 * j + 1];
                        xr[128 * j] = (f32x4){__uint_as_float(h.x << 16) * rstd * wa.x, __uint_as_float(h.x & 0xffff0000u) * rstd * wa.y, __uint_as_float(h.y << 16) * rstd * wa.z, __uint_as_float(h.y & 0xffff0000u) * rstd * wa.w};
                        xr[128 * j + 1] = (f32x4){__uint_as_float(h.z << 16) * rstd * wb.x, __uint_as_float(h.z & 0xffff0000u) * rstd * wb.y, __uint_as_float(h.w << 16) * rstd * wb.z, __uint_as_float(h.w & 0xffff0000u) * rstd * wb.w}; } } }
        } else {
            const int l = (ph - 1) / 6, s = (ph - 1) - 6 * l;
            if (s == 0 && (PHM & 2)) {
                pg8::Gemm g{(const pg8::bf16_t*)(ws + WS_XN), (const pg8::bf16_t*)(ws + WS_WIN) + (size_t)l * NPROJ_PAD * DM, NTOK, NPROJ, DM};
                pg8::StaticOrder S; S.init(NTOK, NPROJ, G, (int)blockIdx.x);
                pg8::EpiInProj E{(pg8::bf16_t*)(ws + WS_PROJ), (float*)(ws + WS_DT), (const float*)(ws + WS_CS), a->in[6] + l * 16, SSP + (size_t)(2 * l) * NTOK};
                pg8::gemm_phase<pg8::EpiInProj, pg8::StaticOrder>(lds, g, S, E, nullptr);
                dt_side(a, l, SSP + (size_t)(2 * l) * NTOK, wave, lane);
            } else if (s == 1) {
                if (PHM & 4) { cbc_prepass(a, l, tid); xcd_barrier(bar); ssd_mfma(a, l, lds, tid, wave, lane); }
                if (PHM & 8) attn_mfma(a, lds, tid, wave, lane);
            } else if (s == 2 && (PHM & 16)) {
                phase_fixup(a, l, wave, lane);
            } else if (s == 3 && (PHM & 32)) {
                pg8::Gemm g{(const pg8::bf16_t*)(ws + WS_MIX), (const pg8::bf16_t*)(ws + WS_WOUT) + (size_t)l * DM * MIXW, NTOK, DM, MIXW};
                pg8::StaticOrder S; S.init(NTOK, DM, G, (int)blockIdx.x);
                pg8::EpiRes E{(pg8::bf16_t*)(ws + WS_XN), SSP + (size_t)(2 * l + 1) * NTOK};
                pg8::gemm_phase<pg8::EpiRes, pg8::StaticOrder>(lds, g, S, E, nullptr);
            } else if (s == 4 && (PHM & 128)) {
                pg8::Gemm g{(const pg8::bf16_t*)(ws + WS_XN), (const pg8::bf16_t*)(ws + WS_WGU) + (size_t)l * 2 * FFN * DM, NTOK, 2 * FFN, DM};
                pg8::StaticOrder S; S.init(NTOK, 2 * FFN, G, (int)blockIdx.x);
                pg8::EpiGateUp E{(pg8::bf16_t*)(ws + WS_PROJ), SSP + (size_t)(2 * l + 1) * NTOK};
                pg8::gemm_phase<pg8::EpiGateUp, pg8::StaticOrder>(lds, g, S, E, nullptr);
            } else if (s == 5 && (PHM & 256)) {
                pg8::Gemm g{(const pg8::bf16_t*)(ws + WS_PROJ), (const pg8::bf16_t*)(ws + WS_WDN) + (size_t)l * DM * FFN, NTOK, DM, FFN};
                pg8::StaticOrder S; S.init(NTOK, DM, G, (int)blockIdx.x);
                pg8::EpiRes E{(pg8::bf16_t*)(ws + WS_XN), SSP + (size_t)(2 * l + 2) * NTOK};
                pg8::gemm_phase<pg8::EpiRes, pg8::StaticOrder>(lds, g, S, E, nullptr);
            }
        }
        if (ph + 1 < ph_hi) { if (ph_hi > 1000) grid.sync(); else xcd_barrier(bar); }
    }
}

extern "C" void kernel_launch(void* const* d_in, const int* in_sizes, int n_in, void* d_out, int out_size, void* d_ws, size_t ws_size, hipStream_t stream) {
    static int ready = 0;
    if (!ready) {
        if (n_in != 16 || out_size != NTOK * DM || ws_size < WS_END) { fprintf(stderr, "kernel_launch: unexpected shapes (n_in %d, out %d, ws %zu)\n", n_in, out_size, ws_size); ready = -1; return; }
        if (hipFuncSetAttribute((const void*)fwd_kernel, hipFuncAttributeMaxDynamicSharedMemorySize, LDS_BYTES) != hipSuccess) { fprintf(stderr, "kernel_launch: hipFuncSetAttribute failed\n"); ready = -1; return; }
        ready = 1;
    }
    if (ready < 0) return;
    if (hipMemsetAsync(d_ws, 0, 16384, stream) != hipSuccess) { fprintf(stderr, "kernel_launch: memset of the barrier words failed\n"); return; }
    Args a{};
    for (int i = 0; i < 16; ++i) a.in[i] = (const float*)d_in[i];
    a.out = (float*)d_out; a.ws = (unsigned char*)d_ws;
    for (int i = 0; i < 8; ++i) a.inv_freq[i] = (float)pow(500000.0, -(double)(2 * i) / 16.0);
#if ONE_LAUNCH
    a.ph_lo = 0; a.ph_hi = NPHASE;
    void* args[] = {&a};
    hipError_t e = hipLaunchCooperativeKernel((const void*)fwd_kernel, dim3(256), dim3(512), args, LDS_BYTES, stream);
    if (e != hipSuccess) fprintf(stderr, "cooperative launch failed: %s\n", hipGetErrorString(e));
#else
    for (int ph = 0; ph < NPHASE; ++ph) { a.ph_lo = ph; a.ph_hi = ph + 1; hipLaunchKernelGGL(fwd_kernel, dim3(256), dim3(512), LDS_BYTES, stream, a); }
#endif
}
```
